# Optimizing an MI355X kernel written in HIP

```python
import math
import jax, jax.numpy as jnp
from jax import lax
import numpy as np

D_MODEL = 1024
BATCH = 4
SEQ = 8192
DEPTH = 2

CHUNK = 64
MEM_LEN = 256
POOL_GROUPS = 4
POOL_WINDOWS = (2, 4, 8, 16)
POOL_WIDTH = D_MODEL // 2
POOL_GC = POOL_WIDTH // POOL_GROUPS
N_HEADS = 8
HEAD_DIM = 64
ATTN_WIDTH = N_HEADS * HEAD_DIM
IDX_HEADS = 8
IDX_DIM = 64
TOPK_MAX = 256
Q_BLOCK = 128
ATTN_SCALE = HEAD_DIM ** -0.5
IDX_W_SCALE = (IDX_DIM ** -0.5) * (IDX_HEADS ** -0.5)
MEM_HEADS = 4
MEM_HEAD_DIM = 128
MEM_WIDTH = MEM_HEADS * MEM_HEAD_DIM
MEM_SCALE = MEM_HEAD_DIM ** -0.5
N_BRANCH = 3
REL_BUCKETS = 32
REL_MAX_DIST = 1024
EPS = 1e-6
NEG = -1e30
IN_SPLITS = (POOL_WIDTH, POOL_WIDTH,
             ATTN_WIDTH, ATTN_WIDTH, ATTN_WIDTH, ATTN_WIDTH,
             IDX_HEADS * IDX_DIM, IDX_DIM, IDX_HEADS,
             MEM_WIDTH, MEM_WIDTH,
             N_BRANCH * D_MODEL)
IN_COLS = sum(IN_SPLITS)

kernel_name = "hybrid_pool_dsa_mem_gated_trunk"


def rms_norm(x, g):
    x32 = x.astype(jnp.float32)
    y = x32 * lax.rsqrt(jnp.mean(x32 * x32, axis=-1, keepdims=True) + EPS)
    return (y * g.astype(jnp.float32)).astype(x.dtype)


def rel_bucket(rel):
    half = REL_BUCKETS // 2
    max_exact = half // 2
    ret = jnp.where(rel > 0, half, 0)
    n = jnp.abs(rel)
    nf = jnp.maximum(n, 1).astype(jnp.float32)
    large = max_exact + (jnp.log(nf / max_exact) / math.log(REL_MAX_DIST / max_exact)
                         * (half - max_exact)).astype(jnp.int32)
    large = jnp.minimum(large, half - 1)
    return ret + jnp.where(n < max_exact, n, large)


def multi_scale_pool(u, pool_w, pool_scale):
    b, s, _ = u.shape
    ug = u.reshape(b, s, POOL_GROUPS, POOL_GC).astype(jnp.float32)
    cs = jnp.cumsum(ug, axis=1)
    cs = jnp.concatenate([jnp.zeros_like(cs[:, :1]), cs], axis=1)
    t = jnp.arange(s, dtype=jnp.int32)[:, None]
    win = jnp.asarray(POOL_WINDOWS, jnp.int32)[None, :]
    start = jnp.maximum(t + 1 - win, 0)
    grp = jnp.arange(POOL_GROUPS, dtype=jnp.int32)[None, :]
    lo = cs[:, start, grp, :]
    count = (t + 1 - start).astype(jnp.float32)[None, :, :, None]
    pooled = (cs[:, 1:] - lo) / count - ug
    mixed = jnp.einsum('bsgc,gcd->bsgd', pooled.astype(u.dtype), pool_w)
    return mixed.reshape(b, s, POOL_WIDTH) * pool_scale


def dsa_attention(q, k, v, iq, ik, iw, rel_bias):
    b, s = q.shape[:2]
    topk = min(TOPK_MAX, s // 4)
    nb = s // Q_BLOCK
    key_pos = jnp.arange(s, dtype=jnp.int32)
    ik32 = ik.astype(jnp.float32)
    gather = jax.vmap(lambda arr, idx: arr[idx])

    def to_blocks(a):
        return jnp.moveaxis(a.reshape((b, nb, Q_BLOCK) + a.shape[2:]), 1, 0)

    def block(args):
        qb, iqb, iwb, qpos = args
        limit = (qpos // CHUNK + 1) * CHUNK
        sc = jnp.einsum('bqhd,bsd->bqhs', iqb.astype(jnp.float32), ik32)
        index_score = jnp.einsum('bqhs,bqh->bqs', jax.nn.relu(sc),
                                 iwb.astype(jnp.float32) * IDX_W_SCALE)
        admissible = key_pos[None, :] < limit[:, None]
        index_score = jnp.where(admissible[None], index_score, NEG)
        _, idx = lax.top_k(index_score, topk)
        k_sel = gather(k, idx)
        v_sel = gather(v, idx)
        logits = jnp.einsum('bqhd,bqkhd->bqhk', qb, k_sel).astype(jnp.float32) * ATTN_SCALE
        bias = rel_bias[rel_bucket(idx - qpos[None, :, None])]
        logits = logits + jnp.moveaxis(bias, -1, 2).astype(jnp.float32)
        valid = idx < limit[None, :, None]
        logits = jnp.where(valid[:, :, None, :], logits, NEG)
        p = jax.nn.softmax(logits, axis=-1).astype(v.dtype)
        return jnp.einsum('bqhk,bqkhd->bqhd', p, v_sel)

    out = lax.map(block, (to_blocks(q), to_blocks(iq), to_blocks(iw),
                          key_pos.reshape(nb, Q_BLOCK)))
    return jnp.moveaxis(out, 0, 1).reshape(b, s, N_HEADS * HEAD_DIM)


def memory_attention(q, mem_k, mem_v):
    b, s = q.shape[:2]
    logits = jnp.einsum('bshd,bmhd->bhsm', q, mem_k).astype(jnp.float32) * MEM_SCALE
    p = jax.nn.softmax(logits, axis=-1).astype(mem_v.dtype)
    return jnp.einsum('bhsm,bmhd->bshd', p, mem_v).reshape(b, s, MEM_WIDTH)


def setup_inputs(seed: int = 0) -> dict:
    key = jax.random.key(seed)
    ks = jax.random.split(key, 14)
    f32 = jnp.float32
    nrm = lambda k, shape, scale: jax.random.normal(k, shape, f32) * scale
    return {
        "x": nrm(ks[0], (BATCH, SEQ, D_MODEL), 1.0),
        "mem": nrm(ks[1], (BATCH, MEM_LEN, D_MODEL), 1.0),
        "norm_g": 1.0 + nrm(ks[2], (DEPTH, D_MODEL), 0.02),
        "w_in": nrm(ks[3], (DEPTH, D_MODEL, IN_COLS), D_MODEL ** -0.5),
        "pool_w": nrm(ks[4], (DEPTH, POOL_GROUPS, POOL_GC, POOL_GC), POOL_GC ** -0.5),
        "pool_scale": 1.0 + nrm(ks[5], (DEPTH, POOL_WIDTH), 0.02),
        "mem_norm_g": 1.0 + nrm(ks[6], (DEPTH, D_MODEL), 0.02),
        "w_mem_kv": nrm(ks[7], (DEPTH, D_MODEL, 2 * MEM_WIDTH), D_MODEL ** -0.5),
        "w_branch": nrm(ks[8], (DEPTH, N_BRANCH, POOL_WIDTH, D_MODEL), POOL_WIDTH ** -0.5),
        "w_out": nrm(ks[9], (DEPTH, D_MODEL, D_MODEL), D_MODEL ** -0.5),
        "rel_bias": nrm(ks[10], (REL_BUCKETS, N_HEADS), 0.5),
        "final_g": 1.0 + nrm(ks[11], (D_MODEL,), 0.02),
    }


def reference(x, mem, norm_g, w_in, pool_w, pool_scale, mem_norm_g, w_mem_kv,
              w_branch, w_out, rel_bias, final_g):
    b, s, _ = x.shape
    split_points = np.cumsum(np.asarray(IN_SPLITS))[:-1].tolist()
    for l in range(DEPTH):
        h = rms_norm(x, norm_g[l])
        proj = h @ w_in[l]
        (pool_u, pool_z, aq, ak, av, az, iq, ik, iw, mq, mz, gates) = jnp.split(
            proj, split_points, axis=-1)

        y_pool = multi_scale_pool(pool_u, pool_w[l], pool_scale[l]) * jax.nn.silu(pool_z)

        y_attn = dsa_attention(
            aq.reshape(b, s, N_HEADS, HEAD_DIM), ak.reshape(b, s, N_HEADS, HEAD_DIM),
            av.reshape(b, s, N_HEADS, HEAD_DIM), iq.reshape(b, s, IDX_HEADS, IDX_DIM),
            ik, iw, rel_bias) * jax.nn.silu(az)

        mkv = rms_norm(mem, mem_norm_g[l]) @ w_mem_kv[l]
        mk, mv = jnp.split(mkv, 2, axis=-1)
        mm = mem.shape[1]
        y_mem = memory_attention(
            mq.reshape(b, s, MEM_HEADS, MEM_HEAD_DIM),
            mk.reshape(b, mm, MEM_HEADS, MEM_HEAD_DIM),
            mv.reshape(b, mm, MEM_HEADS, MEM_HEAD_DIM)) * jax.nn.silu(mz)

        g = jax.nn.sigmoid(gates).reshape(b, s, N_BRANCH, D_MODEL)
        merged = (g[:, :, 0] * (y_pool @ w_branch[l, 0])
                  + g[:, :, 1] * (y_attn @ w_branch[l, 1])
                  + g[:, :, 2] * (y_mem @ w_branch[l, 2]))
        x = x + merged @ w_out[l]
    return rms_norm(x, final_g)
```

```cpp
#ifndef PRO_MASK
#define PRO_MASK 31
#endif
#include <hip/hip_runtime.h>
#include <stdint.h>
#include <math.h>

typedef _Float16 h16;
typedef _Float16 h16x8 __attribute__((ext_vector_type(8)));
typedef float f32x4 __attribute__((ext_vector_type(4)));

constexpr int Bn = 4, S = 8192, T = Bn * S, D = 1024, DEPTH = 2;
constexpr int IN_COLS = 7752;
constexpr int N1 = 4864;
constexpr float EPS = 1e-6f;
constexpr float IDX_W_SCALE = 0.125f * 0.35355339059327373f;
constexpr float ATTN_SCALE = 0.125f;
constexpr float MEM_SCALE = 0.08838834764831845f;
constexpr int BT_STRIDE = 8256;

constexpr size_t MiB = 1u << 20;
constexpr size_t WS_W1T = 1 * MiB;
constexpr size_t WS_WGT = 20 * MiB;
constexpr size_t WS_WBT = 32 * MiB;
constexpr size_t WS_WOT = 38 * MiB;
constexpr size_t WS_WKVT = 42 * MiB;
constexpr size_t WS_PWT = 50 * MiB;
constexpr size_t WS_BIAS = 51 * MiB;
constexpr size_t WS_MEMN = 52 * MiB;
constexpr size_t WS_MKV = 56 * MiB;
constexpr size_t WS_H = 64 * MiB;
constexpr size_t WS_ARR = 128 * MiB;
constexpr size_t WS_POOLED = 416 * MiB;
constexpr size_t WS_IK = 448 * MiB;
constexpr size_t WS_IW = 452 * MiB;
constexpr int A_POOLU = 0, A_AQ = 1, A_MQ = 2, A_IQ = 3, A_POOLZ = 4, A_AZ = 5, A_MZ = 6, A_AK = 7, A_AV = 8;
constexpr size_t WS_MERGED = WS_ARR + 7 * 32 * MiB;
constexpr size_t WS_BBUF = WS_ARR + 4 * 32 * MiB;

__device__ __forceinline__ float silu_f(float z) { return z / (1.f + __expf(-z)); }
__device__ __forceinline__ float sigm_f(float z) { return 1.f / (1.f + __expf(-z)); }

__device__ __forceinline__ int w1_col(int n) {
    if (n < 3584) return n;
    if (n < 4096) return 3656 + (n - 3584);
    if (n < 4608) return 4168 + (n - 4096);
    if (n < 4672) return 3584 + (n - 4608);
    if (n < 4680) return 3648 + (n - 4672);
    return -1;
}
__global__ void k_convert_w(const float* __restrict__ src, int lds, int K, h16* __restrict__ dst, int ldd, int N, int mode, int coff) {
    __shared__ float tile[32][33];
    const int n0 = blockIdx.x * 32, k0 = blockIdx.y * 32, tx = threadIdx.x & 31, ty = threadIdx.x >> 5;
    for (int i = ty; i < 32; i += 8) {
        const int n = n0 + tx, k = k0 + i;
        int col = (mode == 1) ? w1_col(n) : coff + n;
        float v = 0.f;
        if (n < N && k < K && col >= 0) v = src[(size_t)k * lds + col];
        tile[i][tx] = v;
    }
    __syncthreads();
    for (int i = ty; i < 32; i += 8) {
        const int n = n0 + i, k = k0 + tx;
        if (n < N && k < K) dst[(size_t)n * ldd + k] = (h16)tile[tx][i];
    }
}
__global__ void k_convert_pw(const float* __restrict__ pw, h16* __restrict__ dst) {
    const int idx = blockIdx.x * 256 + threadIdx.x;
    if (idx >= 512 * 256) return;
    const int n = idx >> 8, kp = idx & 255, g = n >> 7, d = n & 127;
    float v = 0.f;
    if ((kp >> 7) == (g & 1)) v = pw[((size_t)g * 128 + (kp & 127)) * 128 + d];
    dst[idx] = (h16)v;
}
__global__ void k_bias_tab(const float* __restrict__ rel_bias, float* __restrict__ tab) {
    const int r = blockIdx.x * 256 + threadIdx.x;
    if (r >= 8255) return;
    const int rel = r - 8191;
    int ret = rel > 0 ? 16 : 0;
    const int n = rel < 0 ? -rel : rel;
    int bk;
    if (n < 8) bk = n;
    else {
        const float nf = (float)n;
        int large = 8 + (int)(logf(nf / 8.0f) / logf(128.0f) * 8.0f);
        bk = large < 15 ? large : 15;
    }
    ret += bk;
    for (int h = 0; h < 8; ++h) tab[h * BT_STRIDE + r] = rel_bias[ret * 8 + h];
}

__device__ __forceinline__ float wave_sum(float v) {
#pragma unroll
    for (int o = 1; o < 64; o <<= 1) v += __shfl_xor(v, o);
    return v;
}
template <bool OUT_F32>
__global__ void k_rmsnorm(const float* x, const float* __restrict__ g, void* out, int rows) {
    const int row = blockIdx.x * 4 + (threadIdx.x >> 6), lane = threadIdx.x & 63;
    if (row >= rows) return;
    const f32x4* xr = (const f32x4*)(x + (size_t)row * D) + lane;
    f32x4 v[4]; float s = 0.f;
#pragma unroll
    for (int j = 0; j < 4; ++j) { v[j] = xr[64 * j]; s += v[j].x * v[j].x + v[j].y * v[j].y + v[j].z * v[j].z + v[j].w * v[j].w; }
    const float r = rsqrtf(wave_sum(s) * (1.f / D) + EPS);
#pragma unroll
    for (int j = 0; j < 4; ++j) {
        const f32x4 gg = ((const f32x4*)g)[lane + 64 * j];
        f32x4 o = v[j] * r * gg;
        if (OUT_F32) ((f32x4*)((float*)out + (size_t)row * D))[lane + 64 * j] = o;
        else { h16* op = (h16*)out + (size_t)row * D + (lane + 64 * j) * 4; op[0] = (h16)o.x; op[1] = (h16)o.y; op[2] = (h16)o.z; op[3] = (h16)o.w; }
    }
}

template <class Epi>
__global__ __launch_bounds__(256) void k_gemm(const h16* __restrict__ A, int lda, size_t a_tile_off, const h16* __restrict__ Bt, int ldb, int K, Epi epi) {
    __shared__ __attribute__((aligned(16))) h16 sA[64][40];
    __shared__ __attribute__((aligned(16))) h16 sB[64][40];
    const int bm = blockIdx.y * 64, bn = blockIdx.x * 64;
    const int tid = threadIdx.x, lane = tid & 63, wid = tid >> 6, wr = wid >> 1, wc = wid & 1, fr = lane & 15, fq = lane >> 4;
    const h16* Ab = A + (size_t)(bn >> 8) * a_tile_off;
    f32x4 acc[2][2];
#pragma unroll
    for (int i = 0; i < 2; ++i)
#pragma unroll
        for (int j = 0; j < 2; ++j) acc[i][j] = (f32x4){0.f, 0.f, 0.f, 0.f};
    const int lr = tid >> 2, lc = (tid & 3) * 8;
    for (int k0 = 0; k0 < K; k0 += 32) {
        *(h16x8*)&sA[lr][lc] = *(const h16x8*)(Ab + (size_t)(bm + lr) * lda + k0 + lc);
        *(h16x8*)&sB[lr][lc] = *(const h16x8*)(Bt + (size_t)(bn + lr) * ldb + k0 + lc);
        __syncthreads();
        h16x8 a[2], b[2];
#pragma unroll
        for (int i = 0; i < 2; ++i) a[i] = *(const h16x8*)&sA[wr * 32 + i * 16 + fr][fq * 8];
#pragma unroll
        for (int j = 0; j < 2; ++j) b[j] = *(const h16x8*)&sB[wc * 32 + j * 16 + fr][fq * 8];
#pragma unroll
        for (int i = 0; i < 2; ++i)
#pragma unroll
            for (int j = 0; j < 2; ++j) acc[i][j] = __builtin_amdgcn_mfma_f32_16x16x32_f16(a[i], b[j], acc[i][j], 0, 0, 0);
        __syncthreads();
    }
#pragma unroll
    for (int i = 0; i < 2; ++i)
#pragma unroll
        for (int j = 0; j < 2; ++j)
#pragma unroll
            for (int r = 0; r < 4; ++r) epi(bm + wr * 32 + i * 16 + fq * 4 + r, bn + wc * 32 + j * 16 + fr, acc[i][j][r]);
}
struct EpiProj {
    h16* arr; h16* ik; float* iw;
    __device__ __forceinline__ void operator()(int row, int col, float v) const {
        if (col < 4608) {
            const int a = col >> 9, c = col & 511;
            const int slot = (a == 0) ? A_POOLU : (a == 1) ? A_POOLZ : (a == 2) ? A_AQ : (a == 3) ? A_AK : (a == 4) ? A_AV : (a == 5) ? A_AZ : (a == 6) ? A_IQ : (a == 7) ? A_MQ : A_MZ;
            arr[(size_t)slot * ((size_t)T * 512) + (size_t)row * 512 + c] = (h16)v;
        } else if (col < 4672) ik[(size_t)row * 64 + (col - 4608)] = (h16)v;
        else if (col < 4680) iw[(size_t)row * 8 + (col - 4672)] = v * IDX_W_SCALE;
    }
};
struct EpiStoreH {
    h16* dst; int ld; int pad;
    __device__ __forceinline__ void operator()(int row, int col, float v) const { dst[(size_t)row * ld + col] = (h16)v; }
};
struct EpiPoolMix {
    const h16* z; const float* scale; h16* y;
    __device__ __forceinline__ void operator()(int row, int col, float v) const {
        const float zz = (float)z[(size_t)row * 512 + col];
        y[(size_t)row * 512 + col] = (h16)(v * scale[col] * silu_f(zz));
    }
};
struct EpiMerge {
    const h16* bbuf; h16* merged; int first; int pad;
    __device__ __forceinline__ void operator()(int row, int col, float v) const {
        const size_t o = (size_t)row * 1024 + col;
        float m = sigm_f(v) * (float)bbuf[o];
        if (!first) m += (float)merged[o];
        merged[o] = (h16)m;
    }
};
struct EpiOut {
    const float* xin; float* xout;
    __device__ __forceinline__ void operator()(int row, int col, float v) const { const size_t o = (size_t)row * 1024 + col; xout[o] = xin[o] + v; }
};

__global__ void k_pooled(const h16* __restrict__ u, h16* __restrict__ pooled) {
    const size_t idx = (size_t)blockIdx.x * 256 + threadIdx.x;
    const int c = (int)(idx & 511); const int t = (int)(idx >> 9); const int pos = t & (S - 1);
    const int w = 2 << (c >> 7);
    const int cnt = pos + 1 < w ? pos + 1 : w;
    float s = 0.f;
    for (int i = 0; i < cnt; ++i) s += (float)u[(size_t)(t - i) * 512 + c];
    pooled[idx] = (h16)(s / (float)cnt - (float)u[idx]);
}

__device__ __forceinline__ float block_max(float v, float* red) {
#pragma unroll
    for (int o = 1; o < 64; o <<= 1) v = fmaxf(v, __shfl_xor(v, o));
    __syncthreads();
    if ((threadIdx.x & 63) == 0) red[threadIdx.x >> 6] = v;
    __syncthreads();
    return fmaxf(fmaxf(red[0], red[1]), fmaxf(red[2], red[3]));
}
__device__ __forceinline__ float block_sum(float v, float* red) {
    v = wave_sum(v);
    __syncthreads();
    if ((threadIdx.x & 63) == 0) red[threadIdx.x >> 6] = v;
    __syncthreads();
    return (red[0] + red[1]) + (red[2] + red[3]);
}
__device__ __forceinline__ int block_sum_i(int v, int* red) {
#pragma unroll
    for (int o = 1; o < 64; o <<= 1) v += __shfl_xor(v, o);
    __syncthreads();
    if ((threadIdx.x & 63) == 0) red[threadIdx.x >> 6] = v;
    __syncthreads();
    return (red[0] + red[1]) + (red[2] + red[3]);
}
__device__ __forceinline__ int block_exscan(int v, int* red, int* tot) {
    const int lane = threadIdx.x & 63, w = threadIdx.x >> 6;
    int inc = v;
#pragma unroll
    for (int o = 1; o < 64; o <<= 1) { int t = __shfl_up(inc, o); if (lane >= o) inc += t; }
    __syncthreads();
    if (lane == 63) red[w] = inc;
    __syncthreads();
    int base = 0;
    for (int i = 0; i < w; ++i) base += red[i];
    *tot = red[0] + red[1] + red[2] + red[3];
    return base + inc - v;
}

__global__ __launch_bounds__(256) void k_memattn(const h16* mq, const h16* __restrict__ mkv, const h16* __restrict__ mz, h16* ymem) {
    __shared__ float sq[512]; __shared__ float sp[256]; __shared__ float red[4];
    const int t = blockIdx.x, b = t / S, tid = threadIdx.x;
    sq[tid] = (float)mq[(size_t)t * 512 + tid]; sq[tid + 256] = (float)mq[(size_t)t * 512 + 256 + tid];
    __syncthreads();
    for (int h = 0; h < 4; ++h) {
        const h16* kr = mkv + (size_t)(b * 256 + tid) * 1024 + h * 128;
        float s = 0.f;
        for (int d = 0; d < 128; ++d) s += sq[h * 128 + d] * (float)kr[d];
        s *= MEM_SCALE;
        const float mx = block_max(s, red);
        const float p = __expf(s - mx);
        const float sum = block_sum(p, red);
        sp[tid] = p;
        __syncthreads();
        if (tid < 128) {
            float o = 0.f;
            for (int j = 0; j < 256; ++j) o += sp[j] * (float)mkv[(size_t)(b * 256 + j) * 1024 + 512 + h * 128 + tid];
            o /= sum;
            const float z = (float)mz[(size_t)t * 512 + h * 128 + tid];
            ymem[(size_t)t * 512 + h * 128 + tid] = (h16)(o * silu_f(z));
        }
        __syncthreads();
    }
}

__device__ __forceinline__ unsigned okey(float f) { const unsigned u = __float_as_uint(f); return (u & 0x80000000u) ? ~u : (u | 0x80000000u); }
__global__ __launch_bounds__(256) void k_dsa(const h16* aq, const h16* __restrict__ ak, const h16* __restrict__ av, const h16* __restrict__ az, const h16* __restrict__ iq,
                                            const h16* __restrict__ ik, const float* __restrict__ iw, const float* __restrict__ btab, h16* yattn) {
    __shared__ unsigned sc[8192];
    __shared__ float siq[512]; __shared__ float sqa[512]; __shared__ float sw[8];
    __shared__ int sel[256]; __shared__ float lg[8][256]; __shared__ float red[4]; __shared__ int redi[4]; __shared__ float spsum[8];
    const int t = blockIdx.x, b = t / S, pos = t % S, L = (pos / 64 + 1) * 64, tid = threadIdx.x;
    siq[tid] = (float)iq[(size_t)t * 512 + tid]; siq[tid + 256] = (float)iq[(size_t)t * 512 + 256 + tid];
    sqa[tid] = (float)aq[(size_t)t * 512 + tid]; sqa[tid + 256] = (float)aq[(size_t)t * 512 + 256 + tid];
    if (tid < 8) sw[tid] = iw[(size_t)t * 8 + tid];
    __syncthreads();
    int nsel;
    if (L <= 256) {
        if (tid < L) sel[tid] = tid;
        nsel = L;
        __syncthreads();
    } else {
        const int chunk = (L + 255) / 256;
        const int s0 = min(L, tid * chunk), s1 = min(L, s0 + chunk);
        for (int s = s0; s < s1; ++s) {
            const h16* kr = ik + (size_t)(b * S + s) * 64;
            float I = 0.f;
            for (int h = 0; h < 8; ++h) {
                float d = 0.f;
#pragma unroll 8
                for (int e = 0; e < 64; ++e) d += siq[h * 64 + e] * (float)kr[e];
                I += sw[h] * fmaxf(d, 0.f);
            }
            sc[s] = okey(I);
        }
        __syncthreads();
        unsigned prefix = 0u;
        for (int bit = 31; bit >= 0; --bit) {
            const unsigned cand = prefix | (1u << bit);
            int c = 0;
            for (int s = s0; s < s1; ++s) c += (sc[s] >= cand) ? 1 : 0;
            c = block_sum_i(c, redi);
            if (c >= 256) prefix = cand;
        }
        int cg = 0, ce = 0;
        for (int s = s0; s < s1; ++s) { cg += (sc[s] > prefix) ? 1 : 0; ce += (sc[s] == prefix) ? 1 : 0; }
        const int cgt = block_sum_i(cg, redi);
        const int r = 256 - cgt;
        int tot;
        const int tie_before = block_exscan(ce, redi, &tot);
        int myc = 0; int tb = tie_before;
        for (int s = s0; s < s1; ++s) { const unsigned k = sc[s]; if (k > prefix) ++myc; else if (k == prefix) { if (tb < r) ++myc; ++tb; } }
        int tot2;
        int p = block_exscan(myc, redi, &tot2);
        tb = tie_before;
        for (int s = s0; s < s1; ++s) { const unsigned k = sc[s]; bool take = false; if (k > prefix) take = true; else if (k == prefix) { take = tb < r; ++tb; } if (take) sel[p++] = s; }
        nsel = tot2;
        __syncthreads();
    }
    if (tid < nsel) {
        const int s = sel[tid];
        const h16* kr = ak + (size_t)(b * S + s) * 512;
        for (int h = 0; h < 8; ++h) {
            float d = 0.f;
#pragma unroll 8
            for (int e = 0; e < 64; ++e) d += sqa[h * 64 + e] * (float)kr[h * 64 + e];
            lg[h][tid] = d * ATTN_SCALE + btab[h * BT_STRIDE + (s - pos + 8191)];
        }
    }
    __syncthreads();
    for (int h = 0; h < 8; ++h) {
        const float v = tid < nsel ? lg[h][tid] : -INFINITY;
        const float mx = block_max(v, red);
        const float p = tid < nsel ? __expf(v - mx) : 0.f;
        { const float ps = block_sum(p, red); if (tid == 0) spsum[h] = ps; }
        if (tid < nsel) lg[h][tid] = p;
    }
    __syncthreads();
    for (int o = tid; o < 512; o += 256) {
        const int h = o >> 6;
        float acc = 0.f;
        for (int j = 0; j < nsel; ++j) acc += lg[h][j] * (float)av[(size_t)(b * S + sel[j]) * 512 + o];
        acc /= spsum[h];
        const float z = (float)az[(size_t)t * 512 + o];
        yattn[(size_t)t * 512 + o] = (h16)(acc * silu_f(z));
    }
}

template <class Epi>
static void gemm(hipStream_t st, const h16* A, int lda, size_t a_tile_off, const h16* Bt, int ldb, int M, int N, int K, Epi e) {
    hipLaunchKernelGGL(k_gemm<Epi>, dim3(N / 64, M / 64), dim3(256), 0, st, A, lda, a_tile_off, Bt, ldb, K, e);
}
static void convw(hipStream_t st, const float* src, int lds, int K, h16* dst, int ldd, int N, int mode, int coff) {
    hipLaunchKernelGGL(k_convert_w, dim3((N + 31) / 32, (K + 31) / 32), dim3(256), 0, st, src, lds, K, dst, ldd, N, mode, coff);
}

extern "C" void kernel_launch(void* const* d_in, const int* in_sizes, int n_in, void* d_out, int out_size, void* d_ws, size_t ws_size, hipStream_t stream) {
    const float* x = (const float*)d_in[0]; const float* mem = (const float*)d_in[1]; const float* norm_g = (const float*)d_in[2];
    const float* w_in = (const float*)d_in[3]; const float* pool_w = (const float*)d_in[4]; const float* pool_scale = (const float*)d_in[5];
    const float* mem_norm_g = (const float*)d_in[6]; const float* w_mem_kv = (const float*)d_in[7]; const float* w_branch = (const float*)d_in[8];
    const float* w_out = (const float*)d_in[9]; const float* rel_bias = (const float*)d_in[10]; const float* final_g = (const float*)d_in[11];
    char* ws = (char*)d_ws; float* out = (float*)d_out;
    h16* W1T = (h16*)(ws + WS_W1T); h16* WGT = (h16*)(ws + WS_WGT); h16* WBT = (h16*)(ws + WS_WBT); h16* WOT = (h16*)(ws + WS_WOT);
    h16* WKVT = (h16*)(ws + WS_WKVT); h16* PWT = (h16*)(ws + WS_PWT); float* BT = (float*)(ws + WS_BIAS);
    h16* MEMN = (h16*)(ws + WS_MEMN); h16* MKV = (h16*)(ws + WS_MKV); h16* H = (h16*)(ws + WS_H); h16* ARR = (h16*)(ws + WS_ARR);
    h16* POOLED = (h16*)(ws + WS_POOLED); h16* IK = (h16*)(ws + WS_IK); float* IW = (float*)(ws + WS_IW);
    h16* MERGED = (h16*)(ws + WS_MERGED); h16* BBUF = (h16*)(ws + WS_BBUF);
    const size_t ASZ = (size_t)T * 512;
    for (int l = 0; l < DEPTH; ++l) {
        if (PRO_MASK & 1) {
        convw(stream, w_in + (size_t)l * D * IN_COLS, IN_COLS, D, W1T + (size_t)l * N1 * D, D, N1, 1, 0);
        convw(stream, w_in + (size_t)l * D * IN_COLS, IN_COLS, D, WGT + (size_t)l * 3072 * D, D, 3072, 0, 4680);
        for (int i = 0; i < 3; ++i) convw(stream, w_branch + ((size_t)l * 3 + i) * 512 * 1024, 1024, 512, WBT + ((size_t)l * 3 + i) * 1024 * 512, 512, 1024, 0, 0);
        convw(stream, w_out + (size_t)l * D * D, D, D, WOT + (size_t)l * D * D, D, D, 0, 0);
        convw(stream, w_mem_kv + (size_t)l * D * 1024, 1024, D, WKVT + (size_t)l * 1024 * D, D, 1024, 0, 0);
        }
        if (PRO_MASK & 2) hipLaunchKernelGGL(k_convert_pw, dim3(512), dim3(256), 0, stream, pool_w + (size_t)l * 4 * 128 * 128, PWT + (size_t)l * 512 * 256);
        if (PRO_MASK & 4) hipLaunchKernelGGL(k_rmsnorm<false>, dim3(1024 / 4), dim3(256), 0, stream, mem, mem_norm_g + (size_t)l * D, (void*)(MEMN + (size_t)l * 1024 * D), 1024);
        if (PRO_MASK & 8) gemm(stream, MEMN + (size_t)l * 1024 * D, D, 0, WKVT + (size_t)l * 1024 * D, D, 1024, 1024, D, EpiStoreH{MKV + (size_t)l * 1024 * 1024, 1024, 0});
    }
    if (PRO_MASK & 16) hipLaunchKernelGGL(k_bias_tab, dim3((8255 + 255) / 256), dim3(256), 0, stream, rel_bias, BT);
#ifdef ONLY_PROLOGUE
    hipLaunchKernelGGL(k_rmsnorm<true>, dim3(T / 4), dim3(256), 0, stream, x, final_g, (void*)out, T); return;
#endif
    for (int l = 0; l < DEPTH; ++l) {
        const float* xin = l == 0 ? x : out;
        hipLaunchKernelGGL(k_rmsnorm<false>, dim3(T / 4), dim3(256), 0, stream, xin, norm_g + (size_t)l * D, (void*)H, T);
        gemm(stream, H, D, 0, W1T + (size_t)l * N1 * D, D, T, N1, D, EpiProj{ARR, IK, IW});
        hipLaunchKernelGGL(k_pooled, dim3((unsigned)(ASZ / 256)), dim3(256), 0, stream, ARR + A_POOLU * ASZ, POOLED);
        gemm(stream, POOLED, 512, 256, PWT + (size_t)l * 512 * 256, 256, T, 512, 256, EpiPoolMix{ARR + A_POOLZ * ASZ, pool_scale + (size_t)l * 512, ARR + A_POOLU * ASZ});
        hipLaunchKernelGGL(k_memattn, dim3(T), dim3(256), 0, stream, ARR + A_MQ * ASZ, MKV + (size_t)l * 1024 * 1024, ARR + A_MZ * ASZ, ARR + A_MQ * ASZ);
#ifndef SKIP_DSA
        hipLaunchKernelGGL(k_dsa, dim3(T), dim3(256), 0, stream, ARR + A_AQ * ASZ, ARR + A_AK * ASZ, ARR + A_AV * ASZ, ARR + A_AZ * ASZ, ARR + A_IQ * ASZ, IK, IW, BT, ARR + A_AQ * ASZ);
#endif
        const int yslot[3] = {A_POOLU, A_AQ, A_MQ};
        for (int i = 0; i < 3; ++i) {
            gemm(stream, ARR + yslot[i] * ASZ, 512, 0, WBT + ((size_t)l * 3 + i) * 1024 * 512, 512, T, 1024, 512, EpiStoreH{BBUF, 1024, 0});
            gemm(stream, H, D, 0, WGT + (size_t)l * 3072 * D + (size_t)i * 1024 * D, D, T, 1024, D, EpiMerge{BBUF, MERGED, i == 0 ? 1 : 0, 0});
        }
        gemm(stream, MERGED, D, 0, WOT + (size_t)l * D * D, D, T, 1024, D, EpiOut{xin, out});
    }
    hipLaunchKernelGGL(k_rmsnorm<true>, dim3(T / 4), dim3(256), 0, stream, (const float*)out, final_g, (void*)out, T);
}
```

```cpp
#include <hip/hip_runtime.h>
#include <hip/hip_cooperative_groups.h>
#include <stdio.h>
namespace cg = cooperative_groups;
#include <stdint.h>
#include <math.h>

typedef _Float16 h16;
typedef _Float16 h16x8 __attribute__((ext_vector_type(8)));
typedef float f32x4 __attribute__((ext_vector_type(4)));
typedef _Float16 h16x4 __attribute__((ext_vector_type(4)));

constexpr int Bn = 4, S = 8192, T = Bn * S, D = 1024, DEPTH = 2;
constexpr int IN_COLS = 7752;
constexpr int N1 = 4864;
constexpr float EPS = 1e-6f;
constexpr float IDX_W_SCALE = 0.125f * 0.35355339059327373f;
constexpr float ATTN_SCALE = 0.125f;
constexpr float MEM_SCALE = 0.08838834764831845f;
constexpr int BT_STRIDE = 8256;

constexpr size_t MiB = 1u << 20;
constexpr size_t WS_W1T = 1 * MiB;
constexpr size_t WS_WGT = 20 * MiB;
constexpr size_t WS_WBT = 32 * MiB;
constexpr size_t WS_WOT = 38 * MiB;
constexpr size_t WS_WKVT = 42 * MiB;
constexpr size_t WS_PWT = 50 * MiB;
constexpr size_t WS_BIAS = 51 * MiB;
constexpr size_t WS_MEMN = 52 * MiB;
constexpr size_t WS_MKV = 56 * MiB;
constexpr size_t WS_H = 64 * MiB;
constexpr size_t WS_ARR = 128 * MiB;
constexpr size_t WS_POOLED = 416 * MiB;
constexpr size_t WS_IK = 448 * MiB;
constexpr size_t WS_IW = 452 * MiB;
constexpr int A_POOLU = 0, A_AQ = 1, A_MQ = 2, A_IQ = 3, A_POOLZ = 4, A_AZ = 5, A_MZ = 6, A_AK = 7, A_AV = 8;
constexpr size_t WS_MERGED = WS_ARR + 7 * 32 * MiB;
constexpr size_t WS_BBUF = WS_ARR + 4 * 32 * MiB;

__device__ __forceinline__ float silu_f(float z) { return z / (1.f + __expf(-z)); }
__device__ __forceinline__ float sigm_f(float z) { return 1.f / (1.f + __expf(-z)); }

__device__ __forceinline__ int w1_col(int n) {
    if (n < 3584) return n;
    if (n < 4096) return 3656 + (n - 3584);
    if (n < 4608) return 4168 + (n - 4096);
    if (n < 4672) return 3584 + (n - 4608);
    if (n < 4680) return 3648 + (n - 4672);
    return -1;
}
__device__ __forceinline__ void ph_convert_w(const float* __restrict__ src, int lds, int K, h16* __restrict__ dst, int ldd, int N, int mode, int coff, float* tile  ) {
    const int nbx = (N + 31) / 32, nby = (K + 31) / 32, tx = threadIdx.x & 31, ty = threadIdx.x >> 5;
    for (int vb = blockIdx.x; vb < nbx * nby; vb += gridDim.x) {
        const int n0 = (vb % nbx) * 32, k0 = (vb / nbx) * 32;
        for (int i = ty; i < 32; i += 16) {
            const int n = n0 + tx, k = k0 + i;
            int col = (mode == 1) ? w1_col(n) : coff + n;
            float v = 0.f;
            if (n < N && k < K && col >= 0) v = src[(size_t)k * lds + col];
            tile[i * 33 + tx] = v;
        }
        __syncthreads();
        for (int i = ty; i < 32; i += 16) {
            const int n = n0 + i, k = k0 + tx;
            if (n < N && k < K) dst[(size_t)n * ldd + k] = (h16)tile[tx * 33 + i];
        }
        __syncthreads();
    }
}
__device__ __forceinline__ void ph_convert_pw(const float* __restrict__ pw, h16* __restrict__ dst) {
    for (int idx = blockIdx.x * 512 + threadIdx.x; idx < 512 * 256; idx += gridDim.x * 512) {
        const int n = idx >> 8, kp = idx & 255, g = n >> 7, d = n & 127;
        float v = 0.f;
        if ((kp >> 7) == (g & 1)) v = pw[((size_t)g * 128 + (kp & 127)) * 128 + d];
        dst[idx] = (h16)v;
    }
}
__device__ __forceinline__ void ph_bias_tab(const float* __restrict__ rel_bias, float* __restrict__ tab) {
    for (int r = blockIdx.x * 512 + threadIdx.x; r < 8255; r += gridDim.x * 512) {
        const int rel = r - 8191;
        int ret = rel > 0 ? 16 : 0;
        const int n = rel < 0 ? -rel : rel;
        int bk;
        if (n < 8) bk = n;
        else {
            const float nf = (float)n;
            int large = 8 + (int)(logf(nf / 8.0f) / logf(128.0f) * 8.0f);
            bk = large < 15 ? large : 15;
        }
        ret += bk;
        for (int h = 0; h < 8; ++h) tab[h * BT_STRIDE + r] = rel_bias[ret * 8 + h];
    }
}

__device__ __forceinline__ float wave_sum(float v) {
#pragma unroll
    for (int o = 1; o < 64; o <<= 1) v += __shfl_xor(v, o);
    return v;
}
template <bool OUT_F32>
__device__ __forceinline__ void ph_rmsnorm(const float* x, const float* __restrict__ g, void* out, int rows) {
    const int lane = threadIdx.x & 63;
    for (int row = blockIdx.x * 8 + (threadIdx.x >> 6); row < rows; row += gridDim.x * 8) {
        const f32x4* xr = (const f32x4*)(x + (size_t)row * D) + lane;
        f32x4 v[4]; float s = 0.f;
#pragma unroll
        for (int j = 0; j < 4; ++j) { v[j] = xr[64 * j]; s += v[j].x * v[j].x + v[j].y * v[j].y + v[j].z * v[j].z + v[j].w * v[j].w; }
        const float r = rsqrtf(wave_sum(s) * (1.f / D) + EPS);
#pragma unroll
        for (int j = 0; j < 4; ++j) {
            const f32x4 gg = ((const f32x4*)g)[lane + 64 * j];
            f32x4 o = v[j] * r * gg;
            if (OUT_F32) ((f32x4*)((float*)out + (size_t)row * D))[lane + 64 * j] = o;
            else { h16x4 w = {(h16)o.x, (h16)o.y, (h16)o.z, (h16)o.w}; *(h16x4*)((h16*)out + (size_t)row * D + (lane + 64 * j) * 4) = w; }
        }
    }
}

template <class Epi>
__device__ __forceinline__ void ph_gemm(const h16* __restrict__ A, int lda, size_t a_tile_off, const h16* __restrict__ Bt, int ldb, int M, int N, int K, Epi epi, h16* smem) {
    h16 (*sA)[40] = (h16 (*)[40])smem;
    h16 (*sB)[40] = (h16 (*)[40])(smem + 128 * 40);
    const int tid = threadIdx.x, lane = tid & 63, wid = tid >> 6, wr = wid >> 1, wc = wid & 1, fr = lane & 15, fq = lane >> 4;
    const int nbx = N / 64, nby = M / 128;
    const int lr = tid >> 2, lc = (tid & 3) * 8;
    for (int vb = blockIdx.x; vb < nbx * nby; vb += gridDim.x) {
        const int bm = (vb / nbx) * 128, bn = (vb % nbx) * 64;
        const h16* Ab = A + (size_t)(bn >> 8) * a_tile_off;
        f32x4 acc[2][2];
#pragma unroll
        for (int i = 0; i < 2; ++i)
#pragma unroll
            for (int j = 0; j < 2; ++j) acc[i][j] = (f32x4){0.f, 0.f, 0.f, 0.f};
        for (int k0 = 0; k0 < K; k0 += 32) {
            *(h16x8*)&sA[lr][lc] = *(const h16x8*)(Ab + (size_t)(bm + lr) * lda + k0 + lc);
            if (tid < 256) *(h16x8*)&sB[lr][lc] = *(const h16x8*)(Bt + (size_t)(bn + lr) * ldb + k0 + lc);
            __syncthreads();
            h16x8 a[2], b[2];
#pragma unroll
            for (int i = 0; i < 2; ++i) a[i] = *(const h16x8*)&sA[wr * 32 + i * 16 + fr][fq * 8];
#pragma unroll
            for (int j = 0; j < 2; ++j) b[j] = *(const h16x8*)&sB[wc * 32 + j * 16 + fr][fq * 8];
#pragma unroll
            for (int i = 0; i < 2; ++i)
#pragma unroll
                for (int j = 0; j < 2; ++j) acc[i][j] = __builtin_amdgcn_mfma_f32_16x16x32_f16(a[i], b[j], acc[i][j], 0, 0, 0);
            __syncthreads();
        }
#pragma unroll
        for (int i = 0; i < 2; ++i)
#pragma unroll
            for (int j = 0; j < 2; ++j)
#pragma unroll
                for (int r = 0; r < 4; ++r) epi(bm + wr * 32 + i * 16 + fq * 4 + r, bn + wc * 32 + j * 16 + fr, acc[i][j][r]);
    }
}
struct EpiProj {
    h16* arr; h16* ik; float* iw;
    __device__ __forceinline__ void operator()(int row, int col, float v) const {
        if (col < 4608) {
            const int a = col >> 9, c = col & 511;
            const int slot = (a == 0) ? A_POOLU : (a == 1) ? A_POOLZ : (a == 2) ? A_AQ : (a == 3) ? A_AK : (a == 4) ? A_AV : (a == 5) ? A_AZ : (a == 6) ? A_IQ : (a == 7) ? A_MQ : A_MZ;
            arr[(size_t)slot * ((size_t)T * 512) + (size_t)row * 512 + c] = (h16)v;
        } else if (col < 4672) ik[(size_t)row * 64 + (col - 4608)] = (h16)v;
        else if (col < 4680) iw[(size_t)row * 8 + (col - 4672)] = v * IDX_W_SCALE;
    }
};
struct EpiStoreH {
    h16* dst; int ld;
    __device__ __forceinline__ void operator()(int row, int col, float v) const { dst[(size_t)row * ld + col] = (h16)v; }
};
struct EpiPoolMix {
    const h16* z; const float* scale; h16* y;
    __device__ __forceinline__ void operator()(int row, int col, float v) const {
        const float zz = (float)z[(size_t)row * 512 + col];
        y[(size_t)row * 512 + col] = (h16)(v * scale[col] * silu_f(zz));
    }
};
struct EpiMerge {
    const h16* bbuf; h16* merged; int first;
    __device__ __forceinline__ void operator()(int row, int col, float v) const {
        const size_t o = (size_t)row * 1024 + col;
        float m = sigm_f(v) * (float)bbuf[o];
        if (!first) m += (float)merged[o];
        merged[o] = (h16)m;
    }
};
struct EpiOut {
    const float* xin; float* xout;
    __device__ __forceinline__ void operator()(int row, int col, float v) const { const size_t o = (size_t)row * 1024 + col; xout[o] = xin[o] + v; }
};

__device__ __forceinline__ void ph_pooled(const h16* __restrict__ u, h16* __restrict__ pooled) {
    for (size_t idx = (size_t)blockIdx.x * 512 + threadIdx.x; idx < (size_t)T * 512; idx += (size_t)gridDim.x * 512) {
        const int c = (int)(idx & 511); const int t = (int)(idx >> 9); const int pos = t & (S - 1);
        const int w = 2 << (c >> 7);
        const int cnt = pos + 1 < w ? pos + 1 : w;
        float s = 0.f;
        for (int i = 0; i < cnt; ++i) s += (float)u[(size_t)(t - i) * 512 + c];
        pooled[idx] = (h16)(s / (float)cnt - (float)u[idx]);
    }
}

__device__ __forceinline__ float block_max(float v, float* red) {
#pragma unroll
    for (int o = 1; o < 64; o <<= 1) v = fmaxf(v, __shfl_xor(v, o));
    __syncthreads();
    if ((threadIdx.x & 63) == 0) red[threadIdx.x >> 6] = v;
    __syncthreads();
    return fmaxf(fmaxf(fmaxf(red[0], red[1]), fmaxf(red[2], red[3])), fmaxf(fmaxf(red[4], red[5]), fmaxf(red[6], red[7])));
}
__device__ __forceinline__ float block_sum(float v, float* red) {
    v = wave_sum(v);
    __syncthreads();
    if ((threadIdx.x & 63) == 0) red[threadIdx.x >> 6] = v;
    __syncthreads();
    return ((red[0] + red[1]) + (red[2] + red[3])) + ((red[4] + red[5]) + (red[6] + red[7]));
}
__device__ __forceinline__ int block_sum_i(int v, int* red) {
#pragma unroll
    for (int o = 1; o < 64; o <<= 1) v += __shfl_xor(v, o);
    __syncthreads();
    if ((threadIdx.x & 63) == 0) red[threadIdx.x >> 6] = v;
    __syncthreads();
    return ((red[0] + red[1]) + (red[2] + red[3])) + ((red[4] + red[5]) + (red[6] + red[7]));
}
__device__ __forceinline__ int block_exscan(int v, int* red, int* tot) {
    const int lane = threadIdx.x & 63, w = threadIdx.x >> 6;
    int inc = v;
#pragma unroll
    for (int o = 1; o < 64; o <<= 1) { int t = __shfl_up(inc, o); if (lane >= o) inc += t; }
    __syncthreads();
    if (lane == 63) red[w] = inc;
    __syncthreads();
    int base = 0, all = 0;
#pragma unroll
    for (int i = 0; i < 8; ++i) { const int r = red[i]; if (i < w) base += r; all += r; }
    *tot = all;
    return base + inc - v;
}

__device__ __forceinline__ void ph_memattn(const h16* mq, const h16* __restrict__ mkv, const h16* __restrict__ mz, h16* ymem, float* sm) {
    float* sq = sm; float* sp = sm + 512; float* red = sm + 1024;
    const int tid = threadIdx.x, hh = tid >> 8, j = tid & 255;
    for (int t = blockIdx.x; t < T; t += gridDim.x) {
        const int b = t / S;
        __syncthreads();
        sq[tid] = (float)mq[(size_t)t * 512 + tid];
        __syncthreads();
        for (int hp = 0; hp < 2; ++hp) {
            const int h = hp * 2 + hh;
            const h16* kr = mkv + (size_t)(b * 256 + j) * 1024 + h * 128;
            float s = 0.f;
            for (int d = 0; d < 128; ++d) s += sq[h * 128 + d] * (float)kr[d];
            s *= MEM_SCALE;
            float mx = s;
#pragma unroll
            for (int o = 1; o < 64; o <<= 1) mx = fmaxf(mx, __shfl_xor(mx, o));
            __syncthreads();
            if ((tid & 63) == 0) red[tid >> 6] = mx;
            __syncthreads();
            mx = fmaxf(fmaxf(red[hh * 4], red[hh * 4 + 1]), fmaxf(red[hh * 4 + 2], red[hh * 4 + 3]));
            const float p = __expf(s - mx);
            float sum = wave_sum(p);
            __syncthreads();
            if ((tid & 63) == 0) red[tid >> 6] = sum;
            sp[hh * 256 + j] = p;
            __syncthreads();
            sum = (red[hh * 4] + red[hh * 4 + 1]) + (red[hh * 4 + 2] + red[hh * 4 + 3]);
            if (j < 128) {
                float o = 0.f;
                for (int jj = 0; jj < 256; ++jj) o += sp[hh * 256 + jj] * (float)mkv[(size_t)(b * 256 + jj) * 1024 + 512 + h * 128 + j];
                o /= sum;
                const float z = (float)mz[(size_t)t * 512 + h * 128 + j];
                ymem[(size_t)t * 512 + h * 128 + j] = (h16)(o * silu_f(z));
            }
            __syncthreads();
        }
    }
}

__device__ __forceinline__ unsigned okey(float f) { const unsigned u = __float_as_uint(f); return (u & 0x80000000u) ? ~u : (u | 0x80000000u); }
__device__ __forceinline__ void ph_dsa(const h16* aq, const h16* __restrict__ ak, const h16* __restrict__ av, const h16* __restrict__ az, const h16* __restrict__ iq,
                                       const h16* __restrict__ ik, const float* __restrict__ iw, const float* __restrict__ btab, h16* yattn, unsigned* sm) {
    unsigned* sc = sm;
    float* siq = (float*)(sm + 8192);
    float* sqa = siq + 512;
    float* sw = sqa + 512;
    float* spsum = sw + 8;
    float* red = spsum + 8;
    int* redi = (int*)(red + 8);
    int* sel = redi + 8;
    float* lg = (float*)(sel + 256);
    const int tid = threadIdx.x;
    for (int t = blockIdx.x; t < T; t += gridDim.x) {
        const int b = t / S, pos = t % S, L = (pos / 64 + 1) * 64;
        __syncthreads();
        siq[tid] = (float)iq[(size_t)t * 512 + tid];
        sqa[tid] = (float)aq[(size_t)t * 512 + tid];
        if (tid < 8) sw[tid] = iw[(size_t)t * 8 + tid];
        __syncthreads();
        int nsel;
        if (L <= 256) {
            if (tid < L) sel[tid] = tid;
            nsel = L;
            __syncthreads();
        } else {
            const int chunk = (L + 511) / 512;
            const int s0 = min(L, tid * chunk), s1 = min(L, s0 + chunk);
            for (int s = s0; s < s1; ++s) {
                const h16* kr = ik + (size_t)(b * S + s) * 64;
                float I = 0.f;
                for (int h = 0; h < 8; ++h) {
                    float d = 0.f;
#pragma unroll 8
                    for (int e = 0; e < 64; ++e) d += siq[h * 64 + e] * (float)kr[e];
                    I += sw[h] * fmaxf(d, 0.f);
                }
                sc[s] = okey(I);
            }
            __syncthreads();
            unsigned prefix = 0u;
            for (int bit = 31; bit >= 0; --bit) {
                const unsigned cand = prefix | (1u << bit);
                int c = 0;
                for (int s = s0; s < s1; ++s) c += (sc[s] >= cand) ? 1 : 0;
                c = block_sum_i(c, redi);
                if (c >= 256) prefix = cand;
            }
            int cg_ = 0, ce = 0;
            for (int s = s0; s < s1; ++s) { cg_ += (sc[s] > prefix) ? 1 : 0; ce += (sc[s] == prefix) ? 1 : 0; }
            const int cgt = block_sum_i(cg_, redi);
            const int r = 256 - cgt;
            int tot;
            const int tie_before = block_exscan(ce, redi, &tot);
            int myc = 0; int tb = tie_before;
            for (int s = s0; s < s1; ++s) { const unsigned k = sc[s]; if (k > prefix) ++myc; else if (k == prefix) { if (tb < r) ++myc; ++tb; } }
            int tot2;
            int p = block_exscan(myc, redi, &tot2);
            tb = tie_before;
            for (int s = s0; s < s1; ++s) { const unsigned k = sc[s]; bool take = false; if (k > prefix) take = true; else if (k == prefix) { take = tb < r; ++tb; } if (take) sel[p++] = s; }
            nsel = tot2;
            __syncthreads();
        }
        if (tid < nsel) {
            const int s = sel[tid];
            const h16* kr = ak + (size_t)(b * S + s) * 512;
            for (int h = 0; h < 8; ++h) {
                float d = 0.f;
#pragma unroll 8
                for (int e = 0; e < 64; ++e) d += sqa[h * 64 + e] * (float)kr[h * 64 + e];
                lg[h * 256 + tid] = d * ATTN_SCALE + btab[h * BT_STRIDE + (s - pos + 8191)];
            }
        }
        __syncthreads();
        for (int h = 0; h < 8; ++h) {
            const float v = tid < nsel ? lg[h * 256 + tid] : -INFINITY;
            const float mx = block_max(v, red);
            const float p = tid < nsel ? __expf(v - mx) : 0.f;
            const float ps = block_sum(p, red);
            if (tid == 0) spsum[h] = ps;
            if (tid < nsel) lg[h * 256 + tid] = p;
        }
        __syncthreads();
        {
            const int o = tid, h = o >> 6;
            float acc = 0.f;
            for (int j = 0; j < nsel; ++j) acc += lg[h * 256 + j] * (float)av[(size_t)(b * S + sel[j]) * 512 + o];
            acc /= spsum[h];
            const float z = (float)az[(size_t)t * 512 + o];
            yattn[(size_t)t * 512 + o] = (h16)(acc * silu_f(z));
        }
    }
}

struct Params {
    const float *x, *mem, *norm_g, *w_in, *pool_w, *pool_scale, *mem_norm_g, *w_mem_kv, *w_branch, *w_out, *rel_bias, *final_g;
    float* out; char* ws;
};
constexpr int NT = 512;
constexpr int SMEM_BYTES = 48 * 1024;

__global__ void __launch_bounds__(NT) mega(Params p) {
    cg::grid_group grid = cg::this_grid();
    __shared__ __attribute__((aligned(16))) unsigned char smem[SMEM_BYTES];
    char* ws = p.ws; float* out = p.out;
    h16* W1T = (h16*)(ws + WS_W1T); h16* WGT = (h16*)(ws + WS_WGT); h16* WBT = (h16*)(ws + WS_WBT); h16* WOT = (h16*)(ws + WS_WOT);
    h16* WKVT = (h16*)(ws + WS_WKVT); h16* PWT = (h16*)(ws + WS_PWT); float* BT = (float*)(ws + WS_BIAS);
    h16* MEMN = (h16*)(ws + WS_MEMN); h16* MKV = (h16*)(ws + WS_MKV); h16* H = (h16*)(ws + WS_H); h16* ARR = (h16*)(ws + WS_ARR);
    h16* POOLED = (h16*)(ws + WS_POOLED); h16* IK = (h16*)(ws + WS_IK); float* IW = (float*)(ws + WS_IW);
    h16* MERGED = (h16*)(ws + WS_MERGED); h16* BBUF = (h16*)(ws + WS_BBUF);
    const size_t ASZ = (size_t)T * 512;
    for (int l = 0; l < DEPTH; ++l) {
        ph_convert_w(p.w_in + (size_t)l * D * IN_COLS, IN_COLS, D, W1T + (size_t)l * N1 * D, D, N1, 1, 0, (float*)smem);
        ph_convert_w(p.w_in + (size_t)l * D * IN_COLS, IN_COLS, D, WGT + (size_t)l * 3072 * D, D, 3072, 0, 4680, (float*)smem);
        for (int i = 0; i < 3; ++i) ph_convert_w(p.w_branch + ((size_t)l * 3 + i) * 512 * 1024, 1024, 512, WBT + ((size_t)l * 3 + i) * 1024 * 512, 512, 1024, 0, 0, (float*)smem);
        ph_convert_w(p.w_out + (size_t)l * D * D, D, D, WOT + (size_t)l * D * D, D, D, 0, 0, (float*)smem);
        ph_convert_w(p.w_mem_kv + (size_t)l * D * 1024, 1024, D, WKVT + (size_t)l * 1024 * D, D, 1024, 0, 0, (float*)smem);
        ph_convert_pw(p.pool_w + (size_t)l * 4 * 128 * 128, PWT + (size_t)l * 512 * 256);
        ph_rmsnorm<false>(p.mem, p.mem_norm_g + (size_t)l * D, (void*)(MEMN + (size_t)l * 1024 * D), 1024);
    }
    ph_bias_tab(p.rel_bias, BT);
    ph_rmsnorm<false>(p.x, p.norm_g, (void*)H, T);
    grid.sync();
    for (int l = 0; l < DEPTH; ++l)
        ph_gemm(MEMN + (size_t)l * 1024 * D, D, 0, WKVT + (size_t)l * 1024 * D, D, 1024, 1024, D, EpiStoreH{MKV + (size_t)l * 1024 * 1024, 1024}, (h16*)smem);
    for (int l = 0; l < DEPTH; ++l) {
        const float* xin = l == 0 ? p.x : out;
        if (l > 0) { ph_rmsnorm<false>(xin, p.norm_g + (size_t)l * D, (void*)H, T); grid.sync(); }
        ph_gemm(H, D, 0, W1T + (size_t)l * N1 * D, D, T, N1, D, EpiProj{ARR, IK, IW}, (h16*)smem);
        grid.sync();
        ph_pooled(ARR + A_POOLU * ASZ, POOLED);
        ph_memattn(ARR + A_MQ * ASZ, MKV + (size_t)l * 1024 * 1024, ARR + A_MZ * ASZ, ARR + A_MQ * ASZ, (float*)smem);
        ph_dsa(ARR + A_AQ * ASZ, ARR + A_AK * ASZ, ARR + A_AV * ASZ, ARR + A_AZ * ASZ, ARR + A_IQ * ASZ, IK, IW, BT, ARR + A_AQ * ASZ, (unsigned*)smem);
        grid.sync();
        ph_gemm(POOLED, 512, 256, PWT + (size_t)l * 512 * 256, 256, T, 512, 256, EpiPoolMix{ARR + A_POOLZ * ASZ, p.pool_scale + (size_t)l * 512, ARR + A_POOLU * ASZ}, (h16*)smem);
        grid.sync();
        for (int i = 0; i < 3; ++i) {
            const int slot = i == 0 ? A_POOLU : i == 1 ? A_AQ : A_MQ;
            ph_gemm(ARR + slot * ASZ, 512, 0, WBT + ((size_t)l * 3 + i) * 1024 * 512, 512, T, 1024, 512, EpiStoreH{BBUF, 1024}, (h16*)smem);
            grid.sync();
            ph_gemm(H, D, 0, WGT + (size_t)l * 3072 * D + (size_t)i * 1024 * D, D, T, 1024, D, EpiMerge{BBUF, MERGED, i == 0 ? 1 : 0}, (h16*)smem);
            grid.sync();
        }
        ph_gemm(MERGED, D, 0, WOT + (size_t)l * D * D, D, T, 1024, D, EpiOut{xin, out}, (h16*)smem);
        grid.sync();
    }
    ph_rmsnorm<true>((const float*)out, p.final_g, (void*)out, T);
}

extern "C" void kernel_launch(void* const* d_in, const int* in_sizes, int n_in, void* d_out, int out_size, void* d_ws, size_t ws_size, hipStream_t stream) {
    static int grid_blocks = 0;
    if (!grid_blocks) {
        int dev = 0, cus = 0, per_cu = 0;
        hipGetDevice(&dev);
        hipDeviceGetAttribute(&cus, hipDeviceAttributeMultiprocessorCount, dev);
        hipOccupancyMaxActiveBlocksPerMultiprocessor(&per_cu, mega, NT, 0);
        if (per_cu < 1) per_cu = 1;
        if (per_cu > 2) per_cu = 2;
        grid_blocks = cus * per_cu;
    }
    Params p{};
    p.x = (const float*)d_in[0]; p.mem = (const float*)d_in[1]; p.norm_g = (const float*)d_in[2]; p.w_in = (const float*)d_in[3];
    p.pool_w = (const float*)d_in[4]; p.pool_scale = (const float*)d_in[5]; p.mem_norm_g = (const float*)d_in[6]; p.w_mem_kv = (const float*)d_in[7];
    p.w_branch = (const float*)d_in[8]; p.w_out = (const float*)d_in[9]; p.rel_bias = (const float*)d_in[10]; p.final_g = (const float*)d_in[11];
    p.out = (float*)d_out; p.ws = (char*)d_ws;
    void* args[] = {&p};
    hipError_t e = hipLaunchCooperativeKernel((void*)mega, dim3(grid_blocks), dim3(NT), args, 0, stream);
    if (e != hipSuccess) fprintf(stderr, "cooperative launch failed: %s (grid %d)\n", hipGetErrorString(e), grid_blocks);
}
```

```cpp
#include <hip/hip_runtime.h>
#include <hip/hip_cooperative_groups.h>
#include <stdio.h>
namespace cg = cooperative_groups;
#include <stdint.h>
#include <math.h>

typedef _Float16 h16;
typedef _Float16 h16x8 __attribute__((ext_vector_type(8)));
typedef float f32x4 __attribute__((ext_vector_type(4)));
typedef _Float16 h16x4 __attribute__((ext_vector_type(4)));

constexpr int Bn = 4, S = 8192, T = Bn * S, D = 1024, DEPTH = 2;
constexpr int IN_COLS = 7752;
constexpr int N1 = 4864;
constexpr float EPS = 1e-6f;
constexpr float IDX_W_SCALE = 0.125f * 0.35355339059327373f;
constexpr float ATTN_SCALE = 0.125f;
constexpr float MEM_SCALE = 0.08838834764831845f;
constexpr int BT_STRIDE = 8256;

constexpr size_t MiB = 1u << 20;
constexpr size_t WS_W1T = 1 * MiB;
constexpr size_t WS_WGT = 20 * MiB;
constexpr size_t WS_WBT = 32 * MiB;
constexpr size_t WS_WOT = 38 * MiB;
constexpr size_t WS_WKVT = 42 * MiB;
constexpr size_t WS_PWT = 50 * MiB;
constexpr size_t WS_BIAS = 51 * MiB;
constexpr size_t WS_MEMN = 52 * MiB;
constexpr size_t WS_MKV = 56 * MiB;
constexpr size_t WS_H = 64 * MiB;
constexpr size_t WS_ARR = 128 * MiB;
constexpr size_t WS_POOLED = 416 * MiB;
constexpr size_t WS_IK = 448 * MiB;
constexpr size_t WS_IW = 452 * MiB;
constexpr int A_POOLU = 0, A_AQ = 1, A_MQ = 2, A_IQ = 3, A_POOLZ = 4, A_AZ = 5, A_MZ = 6, A_AK = 7, A_AV = 8;
constexpr size_t WS_MERGED = WS_ARR + 7 * 32 * MiB;
constexpr size_t WS_BBUF = WS_ARR + 4 * 32 * MiB;

__device__ __forceinline__ int opaque_tid() { int t = threadIdx.x; asm volatile("" : "+v"(t)); return t; }
__device__ __forceinline__ float silu_f(float z) { return z / (1.f + __expf(-z)); }
__device__ __forceinline__ float sigm_f(float z) { return 1.f / (1.f + __expf(-z)); }

__device__ __forceinline__ int w1_col(int n) {
    if (n < 3584) return n;
    if (n < 4096) return 3656 + (n - 3584);
    if (n < 4608) return 4168 + (n - 4096);
    if (n < 4672) return 3584 + (n - 4608);
    if (n < 4680) return 3648 + (n - 4672);
    return -1;
}
__device__ __forceinline__ void ph_convert_w(const float* __restrict__ src, int lds, int K, h16* __restrict__ dst, int ldd, int N, int mode, int coff, float* tile  ) {
    const int tix_ = opaque_tid();
    const int nbx = (N + 31) / 32, nby = (K + 31) / 32, tx = tix_ & 31, ty = tix_ >> 5;
    for (int vb = blockIdx.x; vb < nbx * nby; vb += gridDim.x) {
        const int n0 = (vb % nbx) * 32, k0 = (vb / nbx) * 32;
        for (int i = ty; i < 32; i += 16) {
            const int n = n0 + tx, k = k0 + i;
            int col = (mode == 1) ? w1_col(n) : coff + n;
            float v = 0.f;
            if (n < N && k < K && col >= 0) v = src[(size_t)k * lds + col];
            tile[i * 33 + tx] = v;
        }
        __syncthreads();
        for (int i = ty; i < 32; i += 16) {
            const int n = n0 + i, k = k0 + tx;
            if (n < N && k < K) dst[(size_t)n * ldd + k] = (h16)tile[tx * 33 + i];
        }
        __syncthreads();
    }
}
__device__ __forceinline__ void ph_convert_pw(const float* __restrict__ pw, h16* __restrict__ dst) {
    const int tix_ = opaque_tid();
    for (int idx = blockIdx.x * 512 + tix_; idx < 512 * 256; idx += gridDim.x * 512) {
        const int n = idx >> 8, kp = idx & 255, g = n >> 7, d = n & 127;
        float v = 0.f;
        if ((kp >> 7) == (g & 1)) v = pw[((size_t)g * 128 + (kp & 127)) * 128 + d];
        dst[idx] = (h16)v;
    }
}
__device__ __forceinline__ void ph_bias_tab(const float* __restrict__ rel_bias, float* __restrict__ tab) {
    const int tix_ = opaque_tid();
    for (int r = blockIdx.x * 512 + tix_; r < 8255; r += gridDim.x * 512) {
        const int rel = r - 8191;
        int ret = rel > 0 ? 16 : 0;
        const int n = rel < 0 ? -rel : rel;
        int bk;
        if (n < 8) bk = n;
        else {
            const float nf = (float)n;
            int large = 8 + (int)(logf(nf / 8.0f) / logf(128.0f) * 8.0f);
            bk = large < 15 ? large : 15;
        }
        ret += bk;
        for (int h = 0; h < 8; ++h) tab[h * BT_STRIDE + r] = rel_bias[ret * 8 + h];
    }
}

__device__ __forceinline__ float wave_sum(float v) {
#pragma unroll
    for (int o = 1; o < 64; o <<= 1) v += __shfl_xor(v, o);
    return v;
}
template <bool OUT_F32>
__device__ __forceinline__ void ph_rmsnorm(const float* x, const float* __restrict__ g, void* out, int rows) {
    const int tix_ = opaque_tid();
    const int lane = tix_ & 63;
    for (int row = blockIdx.x * 8 + (tix_ >> 6); row < rows; row += gridDim.x * 8) {
        const f32x4* xr = (const f32x4*)(x + (size_t)row * D) + lane;
        f32x4 v[4]; float s = 0.f;
#pragma unroll
        for (int j = 0; j < 4; ++j) { v[j] = xr[64 * j]; s += v[j].x * v[j].x + v[j].y * v[j].y + v[j].z * v[j].z + v[j].w * v[j].w; }
        const float r = rsqrtf(wave_sum(s) * (1.f / D) + EPS);
#pragma unroll
        for (int j = 0; j < 4; ++j) {
            const f32x4 gg = ((const f32x4*)g)[lane + 64 * j];
            f32x4 o = v[j] * r * gg;
            if (OUT_F32) ((f32x4*)((float*)out + (size_t)row * D))[lane + 64 * j] = o;
            else { h16x4 w = {(h16)o.x, (h16)o.y, (h16)o.z, (h16)o.w}; *(h16x4*)((h16*)out + (size_t)row * D + (lane + 64 * j) * 4) = w; }
        }
    }
}

namespace g8 {
#define G8_LAS __attribute__((address_space(3)))
constexpr int BM = 256, BK = 64, HALF = 128, HTB = HALF * BK * 2  , STAGE_BYTES = 8 * HTB;
__device__ __forceinline__ int lds_byte(int r, int c) { const int st = (r >> 4) * 2 + (c >> 5), rr = r & 15, cc = c & 31, ob = rr * 64 + cc * 2; return st * 1024 + (ob ^ (((ob >> 9) & 1) << 5)); }
__device__ __forceinline__ void stage_rc(int b, int& R, int& C) { const int st = b / 1024, sb = b % 1024, swz = sb ^ (((sb >> 9) & 1) << 5); R = (st >> 1) * 16 + swz / 64; C = (st & 1) * 32 + (swz % 64) / 2; }
__device__ __forceinline__ int perm32(int rho) { const int n = rho >> 4, i = rho & 15; return 8 * (i >> 2) + 4 * n + (i & 3); }

typedef G8_LAS unsigned char* G8_LAS_T;
struct Unit {
    const char* A;
    const char* B;
    int lda, ldb, nt;
    int pm, pn, op, aux;
};
template <class Sched, class Epi>
__device__ __forceinline__ void gemm_phase(G8_LAS unsigned char* lds, const Sched& S, const Epi& E) {
    const int tid = opaque_tid(), wid = __builtin_amdgcn_readfirstlane(tid >> 6), lane = tid & 63, wr = wid >> 2, wc = wid & 3, fr = lane & 15, fq = lane >> 4;
    unsigned sR[2], sRb[2], sC[2];
#pragma unroll
    for (int i = 0; i < 2; ++i) { int R, C; stage_rc(tid * 16 + i * 8192, R, C); sR[i] = 2u * R; sC[i] = 2u * C; sRb[i] = 2u * ((R & ~31) + perm32(R & 31)); }
    const size_t kstep = (size_t)(BK * 2);
    const unsigned ldsw = (unsigned)wid * 1024u;
    const int aoff = lds_byte(wr * 64 + fr, fq * 8), boff = lds_byte(wc * 32 + fr, fq * 8);
#define G8_SA(b, h) (((b) * 2 + (h)) * HTB)
#define G8_SB(b, h) ((4 + (b) * 2 + (h)) * HTB)
#define G8_STAGE_A(bufoff, gbase, ld) do { _Pragma("unroll") for (int _i = 0; _i < 2; ++_i) \
        __builtin_amdgcn_global_load_lds((const unsigned*)((const char*)(gbase) + (sR[_i] * (unsigned)(ld) + sC[_i])), (G8_LAS unsigned*)(lds + (bufoff) + ldsw + _i * 8192), 16, 0, 0); } while (0)
#define G8_STAGE_B(bufoff, gbase, ld) do { _Pragma("unroll") for (int _i = 0; _i < 2; ++_i) \
        __builtin_amdgcn_global_load_lds((const unsigned*)((const char*)(gbase) + (sRb[_i] * (unsigned)(ld) + sC[_i])), (G8_LAS unsigned*)(lds + (bufoff) + ldsw + _i * 8192), 16, 0, 0); } while (0)
#define G8_LDA(dst, b, h) do { _Pragma("unroll") for (int m = 0; m < 4; ++m) _Pragma("unroll") for (int k = 0; k < 2; ++k) dst[m][k] = *(const G8_LAS h16x8*)(lds + G8_SA(b, h) + aoff + m * 2048 + k * 1024); } while (0)
#define G8_LDB(dst, b, h) do { _Pragma("unroll") for (int n = 0; n < 2; ++n) _Pragma("unroll") for (int k = 0; k < 2; ++k) dst[n][k] = *(const G8_LAS h16x8*)(lds + G8_SB(b, h) + boff + n * 2048 + k * 1024); } while (0)
#define G8_MMA(ai, bj, At, Bt) do { __builtin_amdgcn_s_setprio(1); _Pragma("unroll") for (int m = 0; m < 4; ++m) _Pragma("unroll") for (int n = 0; n < 2; ++n) _Pragma("unroll") for (int k = 0; k < 2; ++k) \
        acc[ai][bj][m][n] = __builtin_amdgcn_mfma_f32_16x16x32_f16(Bt[n][k], At[m][k], acc[ai][bj][m][n], 0, 0, 0); __builtin_amdgcn_s_setprio(0); } while (0)
#define G8_WAIT_V(n) asm volatile("s_waitcnt vmcnt(" #n ")" ::: "memory")
#define G8_WAIT_L(n) asm volatile("s_waitcnt lgkmcnt(" #n ")" ::: "memory")
#define G8_BAR __builtin_amdgcn_s_barrier()
#define G8_SCHED __builtin_amdgcn_sched_barrier(0)
    Unit cur, nxt; int ui = 0;
    if (!S.next(0, cur)) return;
    f32x4 acc[2][2][4][2];
#pragma unroll
    for (int a = 0; a < 2; ++a)
#pragma unroll
        for (int b = 0; b < 2; ++b)
#pragma unroll
            for (int m = 0; m < 4; ++m)
#pragma unroll
                for (int n = 0; n < 2; ++n) acc[a][b][m][n] = (f32x4){0.f, 0.f, 0.f, 0.f};
    h16x8 At[4][2], B0[2][2], B1[2][2];
    const char* cA = cur.A; const char* cB = cur.B;
    int clda = cur.lda, cldb = cur.ldb;
    unsigned chA = (unsigned)HALF * clda * 2, chB = (unsigned)HALF * cldb * 2;
    G8_STAGE_B(G8_SB(0, 0), cB, cldb); G8_STAGE_B(G8_SB(0, 1), cB + chB, cldb); G8_STAGE_A(G8_SA(0, 0), cA, clda); G8_STAGE_A(G8_SA(0, 1), cA + chA, clda);
    if (wr == 1) G8_BAR;
    G8_WAIT_V(2); G8_BAR;
    G8_STAGE_B(G8_SB(1, 0), cB + kstep, cldb); G8_STAGE_A(G8_SA(1, 0), cA + kstep, clda); G8_STAGE_B(G8_SB(1, 1), cB + chB + kstep, cldb);
    G8_WAIT_V(6); G8_BAR;
    for (;;) {
        const bool has_next = S.next(ui + 1, nxt);
        const char* nA = cA; const char* nB = cB; unsigned nhA = chA, nhB = chB; int nlda = clda, nldb = cldb;
        if (has_next) { nA = nxt.A; nB = nxt.B; nlda = nxt.lda; nldb = nxt.ldb; nhA = (unsigned)HALF * nlda * 2; nhB = (unsigned)HALF * nldb * 2; }
        const int nt = cur.nt;
        for (int t = 0; t < nt; t += 2) {
            const bool last = (t == nt - 2);
            const char* a1 = cA + (size_t)(t + 1) * kstep;
            const char* a2 = last ? nA : cA + (size_t)(t + 2) * kstep; const char* b2 = last ? nB : cB + (size_t)(t + 2) * kstep;
            const char* a3 = a2 + kstep; const char* b3 = b2 + kstep;
            const unsigned h2A = last ? nhA : chA, h2B = last ? nhB : chB;
            const int l2A = last ? nlda : clda, l2B = last ? nldb : cldb;
            G8_LDB(B0, 0, 0); G8_LDB(B1, 0, 1); G8_SCHED; G8_LDA(At, 0, 0); G8_STAGE_A(G8_SA(1, 1), a1 + chA, clda);
            G8_WAIT_V(8); G8_WAIT_L(0); G8_BAR; G8_MMA(0, 0, At, B0); G8_MMA(0, 1, At, B1); G8_BAR; G8_SCHED;
            G8_LDA(At, 0, 1); G8_STAGE_B(G8_SB(0, 0), b2, l2B); G8_STAGE_B(G8_SB(0, 1), b2 + h2B, l2B); G8_STAGE_A(G8_SA(0, 0), a2, l2A);
            G8_WAIT_V(8); G8_WAIT_L(0); G8_BAR; G8_MMA(1, 0, At, B0); G8_MMA(1, 1, At, B1); G8_BAR; G8_SCHED;
            G8_LDB(B0, 1, 0); G8_LDB(B1, 1, 1); G8_SCHED; G8_LDA(At, 1, 0); G8_STAGE_A(G8_SA(0, 1), a2 + h2A, l2A);
            G8_WAIT_V(8); G8_WAIT_L(0); G8_BAR; G8_MMA(0, 0, At, B0); G8_MMA(0, 1, At, B1); G8_BAR; G8_SCHED;
            G8_LDA(At, 1, 1); G8_STAGE_B(G8_SB(1, 0), b3, l2B); G8_STAGE_B(G8_SB(1, 1), b3 + h2B, l2B); G8_STAGE_A(G8_SA(1, 0), a3, l2A);
            G8_WAIT_V(8); G8_WAIT_L(0); G8_BAR; G8_MMA(1, 0, At, B0); G8_MMA(1, 1, At, B1); G8_BAR; G8_SCHED;
        }
        if (wr == 0) G8_BAR;
        E(acc, cur, wr, wc, fr, fq);
        if (!has_next) break;
#pragma unroll
        for (int a = 0; a < 2; ++a)
#pragma unroll
            for (int b = 0; b < 2; ++b)
#pragma unroll
                for (int m = 0; m < 4; ++m)
#pragma unroll
                    for (int n = 0; n < 2; ++n) acc[a][b][m][n] = (f32x4){0.f, 0.f, 0.f, 0.f};
        cur = nxt; cA = nA; cB = nB; chA = nhA; chB = nhB; clda = nlda; cldb = nldb; ++ui;
        if (wr == 1) G8_BAR;
    }
    G8_WAIT_V(0);
    G8_BAR;
#undef G8_SA
#undef G8_SB
#undef G8_STAGE_A
#undef G8_STAGE_B
#undef G8_LDA
#undef G8_LDB
#undef G8_MMA
#undef G8_WAIT_V
#undef G8_WAIT_L
#undef G8_BAR
#undef G8_SCHED
}
}
__device__ __forceinline__ void ph_pooled(const h16* __restrict__ u, h16* __restrict__ pooled) {
    const int tix_ = opaque_tid();
    for (size_t idx = (size_t)blockIdx.x * 512 + tix_; idx < (size_t)T * 512; idx += (size_t)gridDim.x * 512) {
        const int c = (int)(idx & 511); const int t = (int)(idx >> 9); const int pos = t & (S - 1);
        const int w = 2 << (c >> 7);
        const int cnt = pos + 1 < w ? pos + 1 : w;
        float s = 0.f;
        for (int i = 0; i < cnt; ++i) s += (float)u[(size_t)(t - i) * 512 + c];
        pooled[idx] = (h16)(s / (float)cnt - (float)u[idx]);
    }
}

__device__ __forceinline__ float block_max(float v, float* red) {
#pragma unroll
    for (int o = 1; o < 64; o <<= 1) v = fmaxf(v, __shfl_xor(v, o));
    __syncthreads();
    if ((threadIdx.x & 63) == 0) red[threadIdx.x >> 6] = v;
    __syncthreads();
    return fmaxf(fmaxf(fmaxf(red[0], red[1]), fmaxf(red[2], red[3])), fmaxf(fmaxf(red[4], red[5]), fmaxf(red[6], red[7])));
}
__device__ __forceinline__ float block_sum(float v, float* red) {
    v = wave_sum(v);
    __syncthreads();
    if ((threadIdx.x & 63) == 0) red[threadIdx.x >> 6] = v;
    __syncthreads();
    return ((red[0] + red[1]) + (red[2] + red[3])) + ((red[4] + red[5]) + (red[6] + red[7]));
}
__device__ __forceinline__ int block_sum_i(int v, int* red) {
#pragma unroll
    for (int o = 1; o < 64; o <<= 1) v += __shfl_xor(v, o);
    __syncthreads();
    if ((threadIdx.x & 63) == 0) red[threadIdx.x >> 6] = v;
    __syncthreads();
    return ((red[0] + red[1]) + (red[2] + red[3])) + ((red[4] + red[5]) + (red[6] + red[7]));
}
__device__ __forceinline__ int block_exscan(int v, int* red, int* tot) {
    const int lane = threadIdx.x & 63, w = threadIdx.x >> 6;
    int inc = v;
#pragma unroll
    for (int o = 1; o < 64; o <<= 1) { int t = __shfl_up(inc, o); if (lane >= o) inc += t; }
    __syncthreads();
    if (lane == 63) red[w] = inc;
    __syncthreads();
    int base = 0, all = 0;
#pragma unroll
    for (int i = 0; i < 8; ++i) { const int r = red[i]; if (i < w) base += r; all += r; }
    *tot = all;
    return base + inc - v;
}

__device__ __forceinline__ void ph_memattn(const h16* mq, const h16* __restrict__ mkv, const h16* __restrict__ mz, h16* ymem, float* sm) {
    const int tix_ = opaque_tid();
    float* sq = sm; float* sp = sm + 512; float* red = sm + 1024;
    const int tid = tix_, hh = tid >> 8, j = tid & 255;
    for (int t = blockIdx.x; t < T; t += gridDim.x) {
        const int b = t / S;
        __syncthreads();
        sq[tid] = (float)mq[(size_t)t * 512 + tid];
        __syncthreads();
        for (int hp = 0; hp < 2; ++hp) {
            const int h = hp * 2 + hh;
            const h16* kr = mkv + (size_t)(b * 256 + j) * 1024 + h * 128;
            float s = 0.f;
            for (int d = 0; d < 128; ++d) s += sq[h * 128 + d] * (float)kr[d];
            s *= MEM_SCALE;
            float mx = s;
#pragma unroll
            for (int o = 1; o < 64; o <<= 1) mx = fmaxf(mx, __shfl_xor(mx, o));
            __syncthreads();
            if ((tid & 63) == 0) red[tid >> 6] = mx;
            __syncthreads();
            mx = fmaxf(fmaxf(red[hh * 4], red[hh * 4 + 1]), fmaxf(red[hh * 4 + 2], red[hh * 4 + 3]));
            const float p = __expf(s - mx);
            float sum = wave_sum(p);
            __syncthreads();
            if ((tid & 63) == 0) red[tid >> 6] = sum;
            sp[hh * 256 + j] = p;
            __syncthreads();
            sum = (red[hh * 4] + red[hh * 4 + 1]) + (red[hh * 4 + 2] + red[hh * 4 + 3]);
            if (j < 128) {
                float o = 0.f;
                for (int jj = 0; jj < 256; ++jj) o += sp[hh * 256 + jj] * (float)mkv[(size_t)(b * 256 + jj) * 1024 + 512 + h * 128 + j];
                o /= sum;
                const float z = (float)mz[(size_t)t * 512 + h * 128 + j];
                ymem[(size_t)t * 512 + h * 128 + j] = (h16)(o * silu_f(z));
            }
            __syncthreads();
        }
    }
}

__device__ __forceinline__ unsigned okey(float f) { const unsigned u = __float_as_uint(f); return (u & 0x80000000u) ? ~u : (u | 0x80000000u); }
__device__ __forceinline__ void ph_dsa(const h16* aq, const h16* __restrict__ ak, const h16* __restrict__ av, const h16* __restrict__ az, const h16* __restrict__ iq,
                                       const h16* __restrict__ ik, const float* __restrict__ iw, const float* __restrict__ btab, h16* yattn, unsigned* sm) {
    const int tix_ = opaque_tid();
    unsigned* sc = sm;
    float* siq = (float*)(sm + 8192);
    float* sqa = siq + 512;
    float* sw = sqa + 512;
    float* spsum = sw + 8;
    float* red = spsum + 8;
    int* redi = (int*)(red + 8);
    int* sel = redi + 8;
    float* lg = (float*)(sel + 256);
    const int tid = tix_;
    for (int t = blockIdx.x; t < T; t += gridDim.x) {
        const int b = t / S, pos = t % S, L = (pos / 64 + 1) * 64;
        __syncthreads();
        siq[tid] = (float)iq[(size_t)t * 512 + tid];
        sqa[tid] = (float)aq[(size_t)t * 512 + tid];
        if (tid < 8) sw[tid] = iw[(size_t)t * 8 + tid];
        __syncthreads();
        int nsel;
        if (L <= 256) {
            if (tid < L) sel[tid] = tid;
            nsel = L;
            __syncthreads();
        } else {
            const int chunk = (L + 511) / 512;
            const int s0 = min(L, tid * chunk), s1 = min(L, s0 + chunk);
            for (int s = s0; s < s1; ++s) {
                const h16* kr = ik + (size_t)(b * S + s) * 64;
                float I = 0.f;
                for (int h = 0; h < 8; ++h) {
                    float d = 0.f;
#pragma unroll 8
                    for (int e = 0; e < 64; ++e) d += siq[h * 64 + e] * (float)kr[e];
                    I += sw[h] * fmaxf(d, 0.f);
                }
                sc[s] = okey(I);
            }
            __syncthreads();
            unsigned prefix = 0u;
            for (int bit = 31; bit >= 0; --bit) {
                const unsigned cand = prefix | (1u << bit);
                int c = 0;
                for (int s = s0; s < s1; ++s) c += (sc[s] >= cand) ? 1 : 0;
                c = block_sum_i(c, redi);
                if (c >= 256) prefix = cand;
            }
            int cg_ = 0, ce = 0;
            for (int s = s0; s < s1; ++s) { cg_ += (sc[s] > prefix) ? 1 : 0; ce += (sc[s] == prefix) ? 1 : 0; }
            const int cgt = block_sum_i(cg_, redi);
            const int r = 256 - cgt;
            int tot;
            const int tie_before = block_exscan(ce, redi, &tot);
            int myc = 0; int tb = tie_before;
            for (int s = s0; s < s1; ++s) { const unsigned k = sc[s]; if (k > prefix) ++myc; else if (k == prefix) { if (tb < r) ++myc; ++tb; } }
            int tot2;
            int p = block_exscan(myc, redi, &tot2);
            tb = tie_before;
            for (int s = s0; s < s1; ++s) { const unsigned k = sc[s]; bool take = false; if (k > prefix) take = true; else if (k == prefix) { take = tb < r; ++tb; } if (take) sel[p++] = s; }
            nsel = tot2;
            __syncthreads();
        }
        if (tid < nsel) {
            const int s = sel[tid];
            const h16* kr = ak + (size_t)(b * S + s) * 512;
            for (int h = 0; h < 8; ++h) {
                float d = 0.f;
#pragma unroll 8
                for (int e = 0; e < 64; ++e) d += sqa[h * 64 + e] * (float)kr[h * 64 + e];
                lg[h * 256 + tid] = d * ATTN_SCALE + btab[h * BT_STRIDE + (s - pos + 8191)];
            }
        }
        __syncthreads();
        for (int h = 0; h < 8; ++h) {
            const float v = tid < nsel ? lg[h * 256 + tid] : -INFINITY;
            const float mx = block_max(v, red);
            const float p = tid < nsel ? __expf(v - mx) : 0.f;
            const float ps = block_sum(p, red);
            if (tid == 0) spsum[h] = ps;
            if (tid < nsel) lg[h * 256 + tid] = p;
        }
        __syncthreads();
        {
            const int o = tid, h = o >> 6;
            float acc = 0.f;
            for (int j = 0; j < nsel; ++j) acc += lg[h * 256 + j] * (float)av[(size_t)(b * S + sel[j]) * 512 + o];
            acc /= spsum[h];
            const float z = (float)az[(size_t)t * 512 + o];
            yattn[(size_t)t * 512 + o] = (h16)(acc * silu_f(z));
        }
    }
}


enum { OP_STORE = 0, OP_IKIW = 1, OP_POOLMIX = 2, OP_GATE = 3, OP_BR0 = 4, OP_BR1 = 5, OP_BR2 = 6, OP_OUT = 7, OP_MKV = 8 };
enum { PH_GEMM1 = 0, PH_POOLMIX = 1, PH_MERGE = 2, PH_OUT = 3 };
constexpr int NXCD = 8, WGM = 8;
struct Bufs {
    char* ws; const float* pool_scale; const float* xin; float* xout;
#define BUF_ACC(name, off, type) __device__ __forceinline__ type* name() const { return (type*)(ws + (off)); }
    BUF_ACC(W1T, WS_W1T, h16) BUF_ACC(WGT, WS_WGT, h16) BUF_ACC(WBT, WS_WBT, h16) BUF_ACC(WOT, WS_WOT, h16) BUF_ACC(WKVT, WS_WKVT, h16) BUF_ACC(PWT, WS_PWT, h16)
    BUF_ACC(MEMN, WS_MEMN, h16) BUF_ACC(MKV, WS_MKV, h16) BUF_ACC(H, WS_H, h16) BUF_ACC(ARR, WS_ARR, h16) BUF_ACC(POOLED, WS_POOLED, h16) BUF_ACC(IK, WS_IK, h16)
    BUF_ACC(MERGED, WS_MERGED, h16) BUF_ACC(GS, WS_BBUF, h16) BUF_ACC(IW, WS_IW, float) BUF_ACC(BT, WS_BIAS, float)
#undef BUF_ACC
};
__device__ __forceinline__ void tile_order(int L, int nM, int nN, int& pm, int& pn) {
    const int nwg = nM * nN;
    int wgid = L; { const int q = nwg / NXCD, r = nwg % NXCD, xcd = wgid % NXCD, off = wgid / NXCD; wgid = (xcd < r ? xcd * (q + 1) : r * (q + 1) + (xcd - r) * q) + off; }
    const int nig = WGM * nN, gid = wgid / nig, fm = gid * WGM, gsz = (nM - fm) < WGM ? (nM - fm) : WGM;
    pm = fm + ((wgid % nig) % gsz); pn = (wgid % nig) / gsz;
}
struct Sched {
    int phase, layer, G, c, vc; Bufs b;
    __device__ __forceinline__ bool next(int i, g8::Unit& u) const {
        const size_t ASZ = (size_t)T * 512;
        if (phase == PH_GEMM1) {
            const int nmain = 128 * 19, L = i * G + c;
            if (L < nmain) {
                int pm, pn; tile_order(L, 128, 19, pm, pn);
                u.A = (const char*)(b.H() + (size_t)pm * 256 * D); u.lda = D;
                u.B = (const char*)(b.W1T() + (size_t)layer * N1 * D + (size_t)pn * 256 * D); u.ldb = D; u.nt = 16; u.pm = pm; u.pn = pn;
                if (pn < 18) {
                    const int a = pn >> 1;
                    const int slot = (a == 0) ? A_POOLU : (a == 1) ? A_POOLZ : (a == 2) ? A_AQ : (a == 3) ? A_AK : (a == 4) ? A_AV : (a == 5) ? A_AZ : (a == 6) ? A_IQ : (a == 7) ? A_MQ : A_MZ;
                    u.op = OP_STORE; u.aux = slot;
                } else { u.op = OP_IKIW; u.aux = 0; }
                return true;
            }
            if (layer == 0 && L < nmain + 32) {
                const int e = L - nmain, ly = e >> 4, pm = (e & 15) >> 2, pn = e & 3;
                u.A = (const char*)(b.MEMN() + (size_t)ly * 1024 * D + (size_t)pm * 256 * D); u.lda = D;
                u.B = (const char*)(b.WKVT() + (size_t)ly * 1024 * D + (size_t)pn * 256 * D); u.ldb = D; u.nt = 16; u.pm = pm; u.pn = pn;
                u.op = OP_MKV; u.aux = ly;
                return true;
            }
            return false;
        } else if (phase == PH_POOLMIX) {
            const int L = i * G + vc; if (L >= 256) return false;
            const int pm = L >> 1, pn = L & 1;
            u.A = (const char*)(b.POOLED() + (size_t)pm * 256 * 512 + pn * 256); u.lda = 512;
            u.B = (const char*)(b.PWT() + (size_t)layer * 512 * 256 + (size_t)pn * 256 * 256); u.ldb = 256; u.nt = 4; u.pm = pm; u.pn = pn;
            u.op = OP_POOLMIX; u.aux = 0;
            return true;
        } else if (phase == PH_MERGE) {
            const int j = i / 6, sub = i - 6 * j, ot = j * G + vc; if (ot >= 512) return false;
            const int pm = ot >> 2, pn = ot & 3, br = sub >> 1;
            u.pm = pm; u.pn = pn;
            if ((sub & 1) == 0) {
                u.A = (const char*)(b.H() + (size_t)pm * 256 * D); u.lda = D;
                u.B = (const char*)(b.WGT() + (size_t)layer * 3072 * D + (size_t)(br * 1024 + pn * 256) * D); u.ldb = D; u.nt = 16;
                u.op = OP_GATE; u.aux = 0;
            } else {
                const int slot = br == 0 ? A_POOLU : br == 1 ? A_AQ : A_MQ;
                u.A = (const char*)(b.ARR() + (size_t)slot * ASZ + (size_t)pm * 256 * 512); u.lda = 512;
                u.B = (const char*)(b.WBT() + ((size_t)layer * 3 + br) * 1024 * 512 + (size_t)pn * 256 * 512); u.ldb = 512; u.nt = 8;
                u.op = OP_BR0 + br; u.aux = 0;
            }
            return true;
        } else {
            const int ot = i * G + vc; if (ot >= 512) return false;
            const int pm = ot >> 2, pn = ot & 3;
            u.A = (const char*)(b.MERGED() + (size_t)pm * 256 * D); u.lda = D;
            u.B = (const char*)(b.WOT() + (size_t)layer * D * D + (size_t)pn * 256 * D); u.ldb = D; u.nt = 16; u.pm = pm; u.pn = pn;
            u.op = OP_OUT; u.aux = 0;
            return true;
        }
    }
};
__device__ __forceinline__ h16x8 cvt8(const f32x4& a, const f32x4& b) { h16x8 r = {(h16)a[0], (h16)a[1], (h16)a[2], (h16)a[3], (h16)b[0], (h16)b[1], (h16)b[2], (h16)b[3]}; return r; }
__device__ __forceinline__ float fast_rcp(float x) { return __builtin_amdgcn_rcpf(x); }
__device__ __forceinline__ float silu_fast(float z) { return z * fast_rcp(1.f + __expf(-z)); }
__device__ __forceinline__ float sigm_fast(float z) { return fast_rcp(1.f + __expf(-z)); }
struct Epi {
    Bufs b;
#define EPI_LOOP(...) _Pragma("unroll") for (int ai = 0; ai < 2; ++ai) _Pragma("unroll") for (int m = 0; m < 4; ++m) { \
        const int rl = ai * 128 + wr * 64 + m * 16 + fr; const size_t rg = (size_t)u.pm * 256 + rl; (void)rg; \
        _Pragma("unroll") for (int bj = 0; bj < 2; ++bj) { const int cl = bj * 128 + wc * 32 + fq * 8; const int j = (ai * 4 + m) * 2 + bj; (void)j; \
            const f32x4 v0 = acc[ai][bj][m][0], v1 = acc[ai][bj][m][1]; __VA_ARGS__ } asm volatile("" ::: "memory"); }
    __device__ __forceinline__ void operator()(const f32x4 (&acc)[2][2][4][2], const g8::Unit& u, int wr_, int wc_, int fr_, int fq_) const {
        const int tid = opaque_tid();
        const int lane = tid & 63, wid = tid >> 6, wr = wid >> 2, wc = wid & 3, fr = lane & 15, fq = lane >> 4;
        const int op = u.op;
        if (op == OP_STORE) {
            h16* dst = b.ARR() + (size_t)u.aux * ((size_t)T * 512) + (u.pn & 1) * 256;
            EPI_LOOP({ *(h16x8*)(dst + rg * 512 + cl) = cvt8(v0, v1); })
        } else if (op == OP_MKV) {
            h16* dst = b.MKV() + (size_t)u.aux * 1024 * 1024 + u.pn * 256;
            EPI_LOOP({ *(h16x8*)(dst + rg * 1024 + cl) = cvt8(v0, v1); })
        } else if (op == OP_IKIW) {
            EPI_LOOP({ if (bj == 0) {
                if (wc < 2) *(h16x8*)(b.IK() + rg * 64 + cl) = cvt8(v0, v1);
                else if (wc == 2 && fq == 0) { *(f32x4*)(b.IW() + rg * 8) = v0 * IDX_W_SCALE; *(f32x4*)(b.IW() + rg * 8 + 4) = v1 * IDX_W_SCALE; } } })
        } else if (op == OP_POOLMIX) {
            EPI_LOOP({
                const int cg_ = u.pn * 256 + cl;
                const h16x8 z = *(const h16x8*)(b.ARR() + (size_t)A_POOLZ * ((size_t)T * 512) + rg * 512 + cg_);
                const f32x4 s0 = *(const f32x4*)(b.pool_scale + cg_), s1 = *(const f32x4*)(b.pool_scale + cg_ + 4);
                f32x4 y0, y1;
                _Pragma("unroll") for (int e = 0; e < 4; ++e) { y0[e] = v0[e] * s0[e] * silu_fast((float)z[e]); y1[e] = v1[e] * s1[e] * silu_fast((float)z[4 + e]); }
                *(h16x8*)(b.ARR() + (size_t)A_POOLU * ((size_t)T * 512) + rg * 512 + cg_) = cvt8(y0, y1); })
        } else if (op == OP_GATE) {
            EPI_LOOP({
                f32x4 g0, g1;
                _Pragma("unroll") for (int e = 0; e < 4; ++e) { g0[e] = sigm_fast(v0[e]); g1[e] = sigm_fast(v1[e]); }
                *(h16x8*)(b.GS() + ((size_t)blockIdx.x * 16 * 512 + (size_t)j * 512 + tid) * 8) = cvt8(g0, g1); })
        } else if (op == OP_OUT) {
            EPI_LOOP({
                const size_t o = rg * 1024 + u.pn * 256 + cl;
                const f32x4 x0 = *(const f32x4*)(b.xin + o), x1 = *(const f32x4*)(b.xin + o + 4);
                *(f32x4*)(b.xout + o) = x0 + v0; *(f32x4*)(b.xout + o + 4) = x1 + v1; })
        } else {
            const bool first = (op == OP_BR0);
            EPI_LOOP({
                const h16x8 g = *(const h16x8*)(b.GS() + ((size_t)blockIdx.x * 16 * 512 + (size_t)j * 512 + tid) * 8);
                f32x4 y0, y1;
                _Pragma("unroll") for (int e = 0; e < 4; ++e) { y0[e] = (float)g[e] * v0[e]; y1[e] = (float)g[4 + e] * v1[e]; }
                h16x8* mp = (h16x8*)(b.MERGED() + rg * 1024 + u.pn * 256 + cl);
                if (!first) { const h16x8 mo = *mp;
                    _Pragma("unroll") for (int e = 0; e < 4; ++e) { y0[e] += (float)mo[e]; y1[e] += (float)mo[4 + e]; } }
                *mp = cvt8(y0, y1); })
        }
    }
#undef EPI_LOOP
};
struct Params {
    const float *x, *mem, *norm_g, *w_in, *pool_w, *pool_scale, *mem_norm_g, *w_mem_kv, *w_branch, *w_out, *rel_bias, *final_g;
    float* out; char* ws;
};
constexpr int NT = 512;
constexpr int LDS_BYTES = 144 * 1024;

__global__ void __launch_bounds__(NT, 2) mega(Params p) {
    cg::grid_group grid = cg::this_grid();
    extern __shared__ __attribute__((aligned(16))) unsigned char smem[];
    char* ws = p.ws; float* out = p.out;
    Bufs b; b.ws = ws; b.pool_scale = p.pool_scale; b.xin = p.x; b.xout = out;
    const size_t ASZ = (size_t)T * 512;
    const int G = gridDim.x, bx = blockIdx.x, vc = (G % 8 == 0) ? (bx % 8) * (G / 8) + bx / 8 : bx;
    g8::G8_LAS_T lds = (g8::G8_LAS_T)smem;
    constexpr int NSTEPS = 2 + 6 * DEPTH;
#pragma unroll 1
    for (int step = 0; step < NSTEPS; ++step) {
        const int l = (step - 1) / 6, k = (step - 1) - 6 * l;
        { char* w_ = p.ws; asm volatile("" : "+s"(w_)); b.ws = w_; }
        float* BT = b.BT(); h16* ARR = b.ARR();
        if (step == 0) {
            for (int ll = 0; ll < DEPTH; ++ll) {
                ph_convert_w(p.w_in + (size_t)ll * D * IN_COLS, IN_COLS, D, b.W1T() + (size_t)ll * N1 * D, D, N1, 1, 0, (float*)smem);
                ph_convert_w(p.w_in + (size_t)ll * D * IN_COLS, IN_COLS, D, b.WGT() + (size_t)ll * 3072 * D, D, 3072, 0, 4680, (float*)smem);
                for (int i = 0; i < 3; ++i) ph_convert_w(p.w_branch + ((size_t)ll * 3 + i) * 512 * 1024, 1024, 512, b.WBT() + ((size_t)ll * 3 + i) * 1024 * 512, 512, 1024, 0, 0, (float*)smem);
                ph_convert_w(p.w_out + (size_t)ll * D * D, D, D, b.WOT() + (size_t)ll * D * D, D, D, 0, 0, (float*)smem);
                ph_convert_w(p.w_mem_kv + (size_t)ll * D * 1024, 1024, D, b.WKVT() + (size_t)ll * 1024 * D, D, 1024, 0, 0, (float*)smem);
                ph_convert_pw(p.pool_w + (size_t)ll * 4 * 128 * 128, b.PWT() + (size_t)ll * 512 * 256);
                ph_rmsnorm<false>(p.mem, p.mem_norm_g + (size_t)ll * D, (void*)(b.MEMN() + (size_t)ll * 1024 * D), 1024);
            }
            ph_bias_tab(p.rel_bias, BT);
        } else if (step == NSTEPS - 1) {
            ph_rmsnorm<true>((const float*)out, p.final_g, (void*)out, T);
        } else {
            b.xin = l == 0 ? p.x : (const float*)out; b.pool_scale = p.pool_scale + (size_t)l * 512;
            if (k == 0) {
                ph_rmsnorm<false>(b.xin, p.norm_g + (size_t)l * D, (void*)b.H(), T);
            } else if (k == 2) {
                ph_pooled(ARR + A_POOLU * ASZ, b.POOLED());
                ph_memattn(ARR + A_MQ * ASZ, b.MKV() + (size_t)l * 1024 * 1024, ARR + A_MZ * ASZ, ARR + A_MQ * ASZ, (float*)smem);
                ph_dsa(ARR + A_AQ * ASZ, ARR + A_AK * ASZ, ARR + A_AV * ASZ, ARR + A_AZ * ASZ, ARR + A_IQ * ASZ, b.IK(), b.IW(), BT, ARR + A_AQ * ASZ, (unsigned*)smem);
            } else {
                const int ph = k == 1 ? PH_GEMM1 : k == 3 ? PH_POOLMIX : k == 4 ? PH_MERGE : PH_OUT;
                Sched s{ph, l, G, bx, vc, b}; Epi e{b}; g8::gemm_phase(lds, s, e);
            }
        }
        if (step < NSTEPS - 1) grid.sync();
    }
}

extern "C" void kernel_launch(void* const* d_in, const int* in_sizes, int n_in, void* d_out, int out_size, void* d_ws, size_t ws_size, hipStream_t stream) {
    static int grid_blocks = 0;
    if (!grid_blocks) {
        int dev = 0, cus = 0, per_cu = 0;
        (void)hipGetDevice(&dev);
        (void)hipDeviceGetAttribute(&cus, hipDeviceAttributeMultiprocessorCount, dev);
        (void)hipFuncSetAttribute((const void*)mega, hipFuncAttributeMaxDynamicSharedMemorySize, LDS_BYTES);
        (void)hipOccupancyMaxActiveBlocksPerMultiprocessor(&per_cu, mega, NT, LDS_BYTES);
        if (per_cu < 1) per_cu = 1;
        grid_blocks = cus * 1;
    }
    Params p{};
    p.x = (const float*)d_in[0]; p.mem = (const float*)d_in[1]; p.norm_g = (const float*)d_in[2]; p.w_in = (const float*)d_in[3];
    p.pool_w = (const float*)d_in[4]; p.pool_scale = (const float*)d_in[5]; p.mem_norm_g = (const float*)d_in[6]; p.w_mem_kv = (const float*)d_in[7];
    p.w_branch = (const float*)d_in[8]; p.w_out = (const float*)d_in[9]; p.rel_bias = (const float*)d_in[10]; p.final_g = (const float*)d_in[11];
    p.out = (float*)d_out; p.ws = (char*)d_ws;
    void* args[] = {&p};
    hipError_t e = hipLaunchCooperativeKernel((void*)mega, dim3(grid_blocks), dim3(NT), args, LDS_BYTES, stream);
    if (e != hipSuccess) fprintf(stderr, "cooperative launch failed: %s (grid %d)\n", hipGetErrorString(e), grid_blocks);
}
```

```cpp
#ifndef PROBE
#define PROBE 0
#endif
#include <hip/hip_runtime.h>
#include <hip/hip_cooperative_groups.h>
#include <stdio.h>
namespace cg = cooperative_groups;
#include <stdint.h>
#include <math.h>

typedef _Float16 h16;
typedef _Float16 h16x8 __attribute__((ext_vector_type(8)));
typedef float f32x4 __attribute__((ext_vector_type(4)));
typedef _Float16 h16x4 __attribute__((ext_vector_type(4)));

constexpr int Bn = 4, S = 8192, T = Bn * S, D = 1024, DEPTH = 2;
constexpr int IN_COLS = 7752;
constexpr int N1 = 4864;
constexpr float EPS = 1e-6f;
constexpr float IDX_W_SCALE = 0.125f * 0.35355339059327373f;
constexpr float ATTN_SCALE = 0.125f;
constexpr float MEM_SCALE = 0.08838834764831845f;
constexpr int BT_STRIDE = 8256;

constexpr size_t MiB = 1u << 20;
constexpr size_t WS_W1T = 1 * MiB;
constexpr size_t WS_WGT = 20 * MiB;
constexpr size_t WS_WBT = 32 * MiB;
constexpr size_t WS_WOT = 38 * MiB;
constexpr size_t WS_WKVT = 42 * MiB;
constexpr size_t WS_PWT = 50 * MiB;
constexpr size_t WS_BIAS = 51 * MiB;
constexpr size_t WS_MEMN = 52 * MiB;
constexpr size_t WS_MKV = 56 * MiB;
constexpr size_t WS_H = 64 * MiB;
constexpr size_t WS_ARR = 128 * MiB;
constexpr size_t WS_POOLED = 416 * MiB;
constexpr size_t WS_IK = 448 * MiB;
constexpr size_t WS_IW = 452 * MiB;
constexpr size_t WS_BKT = 453 * MiB;
constexpr size_t WS_DIAG = 454 * MiB;
constexpr int A_POOLU = 0, A_AQ = 1, A_MQ = 2, A_IQ = 3, A_POOLZ = 4, A_AZ = 5, A_MZ = 6, A_AK = 7, A_AV = 8;
constexpr size_t WS_MERGED = WS_ARR + 7 * 32 * MiB;
constexpr size_t WS_BBUF = WS_ARR + 4 * 32 * MiB;

__device__ __forceinline__ int opaque_tid() { int t = threadIdx.x; asm volatile("" : "+v"(t)); return t; }
__device__ __forceinline__ float fast_rcp(float x) { return __builtin_amdgcn_rcpf(x); }
__device__ __forceinline__ float silu_fast(float z) { return z * fast_rcp(1.f + __expf(-z)); }
__device__ __forceinline__ float sigm_fast(float z) { return fast_rcp(1.f + __expf(-z)); }
__device__ __forceinline__ float silu_f(float z) { return z / (1.f + __expf(-z)); }
__device__ __forceinline__ float sigm_f(float z) { return 1.f / (1.f + __expf(-z)); }

__device__ __forceinline__ int w1_col(int n) {
    if (n < 3584) return n;
    if (n < 4096) return 3656 + (n - 3584);
    if (n < 4608) return 4168 + (n - 4096);
    if (n < 4672) return 3584 + (n - 4608);
    if (n < 4680) return 3648 + (n - 4672);
    return -1;
}
__device__ __forceinline__ void ph_convert_w(const float* __restrict__ src, int lds, int K, h16* __restrict__ dst, int ldd, int N, int mode, int coff, float* tile  ) {
    const int tix_ = opaque_tid();
    const int nbx = (N + 31) / 32, nby = (K + 31) / 32, tx = tix_ & 31, ty = tix_ >> 5;
    for (int vb = blockIdx.x; vb < nbx * nby; vb += gridDim.x) {
        const int n0 = (vb % nbx) * 32, k0 = (vb / nbx) * 32;
        for (int i = ty; i < 32; i += 16) {
            const int n = n0 + tx, k = k0 + i;
            int col = (mode == 1) ? w1_col(n) : coff + n;
            float v = 0.f;
            if (n < N && k < K && col >= 0) v = src[(size_t)k * lds + col];
            tile[i * 33 + tx] = v;
        }
        __syncthreads();
        for (int i = ty; i < 32; i += 16) {
            const int n = n0 + i, k = k0 + tx;
            if (n < N && k < K) dst[(size_t)n * ldd + k] = (h16)tile[tx * 33 + i];
        }
        __syncthreads();
    }
}
__device__ __forceinline__ void ph_convert_pw(const float* __restrict__ pw, h16* __restrict__ dst) {
    const int tix_ = opaque_tid();
    for (int idx = blockIdx.x * 512 + tix_; idx < 512 * 256; idx += gridDim.x * 512) {
        const int n = idx >> 8, kp = idx & 255, g = n >> 7, d = n & 127;
        float v = 0.f;
        if ((kp >> 7) == (g & 1)) v = pw[((size_t)g * 128 + (kp & 127)) * 128 + d];
        dst[idx] = (h16)v;
    }
}
__device__ __forceinline__ void ph_bias_tab(const float* __restrict__ rel_bias, float* __restrict__ tab, int* __restrict__ bkt) {
    const int tix_ = opaque_tid();
    for (int r = blockIdx.x * 512 + tix_; r < 8255; r += gridDim.x * 512) {
        const int rel = r - 8191;
        int ret = rel > 0 ? 16 : 0;
        const int n = rel < 0 ? -rel : rel;
        int bk;
        if (n < 8) bk = n;
        else {
            const float nf = (float)n;
            int large = 8 + (int)(logf(nf / 8.0f) / logf(128.0f) * 8.0f);
            bk = large < 15 ? large : 15;
        }
        ret += bk;
        bkt[r] = ret;
        for (int h = 0; h < 8; ++h) tab[h * BT_STRIDE + r] = rel_bias[ret * 8 + h];
    }
}

__device__ __forceinline__ float wave_sum(float v) {
#pragma unroll
    for (int o = 1; o < 64; o <<= 1) v += __shfl_xor(v, o);
    return v;
}
template <bool OUT_F32>
__device__ __forceinline__ void ph_rmsnorm(const float* x, const float* __restrict__ g, void* out, int rows) {
    const int tix_ = opaque_tid();
    const int lane = tix_ & 63;
    for (int row = blockIdx.x * 8 + (tix_ >> 6); row < rows; row += gridDim.x * 8) {
        const f32x4* xr = (const f32x4*)(x + (size_t)row * D) + lane;
        f32x4 v[4]; float s = 0.f;
#pragma unroll
        for (int j = 0; j < 4; ++j) { v[j] = xr[64 * j]; s += v[j].x * v[j].x + v[j].y * v[j].y + v[j].z * v[j].z + v[j].w * v[j].w; }
        const float r = rsqrtf(wave_sum(s) * (1.f / D) + EPS);
#pragma unroll
        for (int j = 0; j < 4; ++j) {
            const f32x4 gg = ((const f32x4*)g)[lane + 64 * j];
            f32x4 o = v[j] * r * gg;
            if (OUT_F32) ((f32x4*)((float*)out + (size_t)row * D))[lane + 64 * j] = o;
            else { h16x4 w = {(h16)o.x, (h16)o.y, (h16)o.z, (h16)o.w}; *(h16x4*)((h16*)out + (size_t)row * D + (lane + 64 * j) * 4) = w; }
        }
    }
}

namespace g8 {
#define G8_LAS __attribute__((address_space(3)))
constexpr int BM = 256, BK = 64, HALF = 128, HTB = HALF * BK * 2  , STAGE_BYTES = 8 * HTB;
__device__ __forceinline__ int lds_byte(int r, int c) { const int st = (r >> 4) * 2 + (c >> 5), rr = r & 15, cc = c & 31, ob = rr * 64 + cc * 2; return st * 1024 + (ob ^ (((ob >> 9) & 1) << 5)); }
__device__ __forceinline__ void stage_rc(int b, int& R, int& C) { const int st = b / 1024, sb = b % 1024, swz = sb ^ (((sb >> 9) & 1) << 5); R = (st >> 1) * 16 + swz / 64; C = (st & 1) * 32 + (swz % 64) / 2; }
__device__ __forceinline__ int perm32(int rho) { const int n = rho >> 4, i = rho & 15; return 8 * (i >> 2) + 4 * n + (i & 3); }

typedef G8_LAS unsigned char* G8_LAS_T;
struct Unit {
    const char* A;
    const char* B;
    int lda, ldb, nt;
    int pm, pn, op, aux;
};
template <class Sched, class Epi>
__device__ __forceinline__ void gemm_phase(G8_LAS unsigned char* lds, const Sched& S, const Epi& E) {
    const int tid = opaque_tid(), wid = __builtin_amdgcn_readfirstlane(tid >> 6), lane = tid & 63, wr = wid >> 2, wc = wid & 3, fr = lane & 15, fq = lane >> 4;
    unsigned sR[2], sRb[2], sC[2];
#pragma unroll
    for (int i = 0; i < 2; ++i) { int R, C; stage_rc(tid * 16 + i * 8192, R, C); sR[i] = 2u * R; sC[i] = 2u * C; sRb[i] = 2u * ((R & ~31) + perm32(R & 31)); }
    const size_t kstep = (size_t)(BK * 2);
    const unsigned ldsw = (unsigned)wid * 1024u;
    const int aoff = lds_byte(wr * 64 + fr, fq * 8), boff = lds_byte(wc * 32 + fr, fq * 8);
#define G8_SA(b, h) (((b) * 2 + (h)) * HTB)
#define G8_SB(b, h) ((4 + (b) * 2 + (h)) * HTB)
#define G8_STAGE_A(bufoff, gbase, ld) do { _Pragma("unroll") for (int _i = 0; _i < 2; ++_i) \
        __builtin_amdgcn_global_load_lds((const unsigned*)((const char*)(gbase) + (sR[_i] * (unsigned)(ld) + sC[_i])), (G8_LAS unsigned*)(lds + (bufoff) + ldsw + _i * 8192), 16, 0, 0); } while (0)
#define G8_STAGE_B(bufoff, gbase, ld) do { _Pragma("unroll") for (int _i = 0; _i < 2; ++_i) \
        __builtin_amdgcn_global_load_lds((const unsigned*)((const char*)(gbase) + (sRb[_i] * (unsigned)(ld) + sC[_i])), (G8_LAS unsigned*)(lds + (bufoff) + ldsw + _i * 8192), 16, 0, 0); } while (0)
#define G8_LDA(dst, b, h) do { _Pragma("unroll") for (int m = 0; m < 4; ++m) _Pragma("unroll") for (int k = 0; k < 2; ++k) dst[m][k] = *(const G8_LAS h16x8*)(lds + G8_SA(b, h) + aoff + m * 2048 + k * 1024); } while (0)
#define G8_LDB(dst, b, h) do { _Pragma("unroll") for (int n = 0; n < 2; ++n) _Pragma("unroll") for (int k = 0; k < 2; ++k) dst[n][k] = *(const G8_LAS h16x8*)(lds + G8_SB(b, h) + boff + n * 2048 + k * 1024); } while (0)
#define G8_MMA(ai, bj, At, Bt) do { __builtin_amdgcn_s_setprio(1); _Pragma("unroll") for (int m = 0; m < 4; ++m) _Pragma("unroll") for (int n = 0; n < 2; ++n) _Pragma("unroll") for (int k = 0; k < 2; ++k) \
        acc[ai][bj][m][n] = __builtin_amdgcn_mfma_f32_16x16x32_f16(Bt[n][k], At[m][k], acc[ai][bj][m][n], 0, 0, 0); __builtin_amdgcn_s_setprio(0); } while (0)
#define G8_WAIT_V(n) asm volatile("s_waitcnt vmcnt(" #n ")" ::: "memory")
#define G8_WAIT_L(n) asm volatile("s_waitcnt lgkmcnt(" #n ")" ::: "memory")
#define G8_BAR __builtin_amdgcn_s_barrier()
#define G8_SCHED __builtin_amdgcn_sched_barrier(0)
    Unit cur, nxt; int ui = 0;
    if (!S.next(0, cur)) return;
    f32x4 acc[2][2][4][2];
#pragma unroll
    for (int a = 0; a < 2; ++a)
#pragma unroll
        for (int b = 0; b < 2; ++b)
#pragma unroll
            for (int m = 0; m < 4; ++m)
#pragma unroll
                for (int n = 0; n < 2; ++n) acc[a][b][m][n] = (f32x4){0.f, 0.f, 0.f, 0.f};
    h16x8 At[4][2], B0[2][2], B1[2][2];
    const char* cA = cur.A; const char* cB = cur.B;
    int clda = cur.lda, cldb = cur.ldb;
    unsigned chA = (unsigned)HALF * clda * 2, chB = (unsigned)HALF * cldb * 2;
    G8_STAGE_B(G8_SB(0, 0), cB, cldb); G8_STAGE_B(G8_SB(0, 1), cB + chB, cldb); G8_STAGE_A(G8_SA(0, 0), cA, clda); G8_STAGE_A(G8_SA(0, 1), cA + chA, clda);
    if (wr == 1) G8_BAR;
    G8_WAIT_V(2); G8_BAR;
    G8_STAGE_B(G8_SB(1, 0), cB + kstep, cldb); G8_STAGE_A(G8_SA(1, 0), cA + kstep, clda); G8_STAGE_B(G8_SB(1, 1), cB + chB + kstep, cldb);
    G8_WAIT_V(6); G8_BAR;
    for (;;) {
        const bool has_next = S.next(ui + 1, nxt);
        const char* nA = cA; const char* nB = cB; unsigned nhA = chA, nhB = chB; int nlda = clda, nldb = cldb;
        if (has_next) { nA = nxt.A; nB = nxt.B; nlda = nxt.lda; nldb = nxt.ldb; nhA = (unsigned)HALF * nlda * 2; nhB = (unsigned)HALF * nldb * 2; }
        const int nt = cur.nt;
        for (int t = 0; t < nt; t += 2) {
            const bool last = (t == nt - 2);
            const char* a1 = cA + (size_t)(t + 1) * kstep;
            const char* a2 = last ? nA : cA + (size_t)(t + 2) * kstep; const char* b2 = last ? nB : cB + (size_t)(t + 2) * kstep;
            const char* a3 = a2 + kstep; const char* b3 = b2 + kstep;
            const unsigned h2A = last ? nhA : chA, h2B = last ? nhB : chB;
            const int l2A = last ? nlda : clda, l2B = last ? nldb : cldb;
            G8_LDB(B0, 0, 0); G8_LDB(B1, 0, 1); G8_SCHED; G8_LDA(At, 0, 0); G8_STAGE_A(G8_SA(1, 1), a1 + chA, clda);
            G8_WAIT_V(8); G8_WAIT_L(0); G8_BAR; G8_MMA(0, 0, At, B0); G8_MMA(0, 1, At, B1); G8_BAR; G8_SCHED;
            G8_LDA(At, 0, 1); G8_STAGE_B(G8_SB(0, 0), b2, l2B); G8_STAGE_B(G8_SB(0, 1), b2 + h2B, l2B); G8_STAGE_A(G8_SA(0, 0), a2, l2A);
            G8_WAIT_V(8); G8_WAIT_L(0); G8_BAR; G8_MMA(1, 0, At, B0); G8_MMA(1, 1, At, B1); G8_BAR; G8_SCHED;
            G8_LDB(B0, 1, 0); G8_LDB(B1, 1, 1); G8_SCHED; G8_LDA(At, 1, 0); G8_STAGE_A(G8_SA(0, 1), a2 + h2A, l2A);
            G8_WAIT_V(8); G8_WAIT_L(0); G8_BAR; G8_MMA(0, 0, At, B0); G8_MMA(0, 1, At, B1); G8_BAR; G8_SCHED;
            G8_LDA(At, 1, 1); G8_STAGE_B(G8_SB(1, 0), b3, l2B); G8_STAGE_B(G8_SB(1, 1), b3 + h2B, l2B); G8_STAGE_A(G8_SA(1, 0), a3, l2A);
            G8_WAIT_V(8); G8_WAIT_L(0); G8_BAR; G8_MMA(1, 0, At, B0); G8_MMA(1, 1, At, B1); G8_BAR; G8_SCHED;
        }
        if (wr == 0) G8_BAR;
        E(acc, cur, wr, wc, fr, fq);
        if (!has_next) break;
#pragma unroll
        for (int a = 0; a < 2; ++a)
#pragma unroll
            for (int b = 0; b < 2; ++b)
#pragma unroll
                for (int m = 0; m < 4; ++m)
#pragma unroll
                    for (int n = 0; n < 2; ++n) acc[a][b][m][n] = (f32x4){0.f, 0.f, 0.f, 0.f};
        cur = nxt; cA = nA; cB = nB; chA = nhA; chB = nhB; clda = nlda; cldb = nldb; ++ui;
        if (wr == 1) G8_BAR;
    }
    G8_WAIT_V(0);
    G8_BAR;
#undef G8_SA
#undef G8_SB
#undef G8_STAGE_A
#undef G8_STAGE_B
#undef G8_LDA
#undef G8_LDB
#undef G8_MMA
#undef G8_WAIT_V
#undef G8_WAIT_L
#undef G8_BAR
#undef G8_SCHED
}
}
__device__ __forceinline__ void ph_pooled(const h16* __restrict__ u, h16* __restrict__ pooled) {
    const int tix_ = opaque_tid();
    for (size_t idx = (size_t)blockIdx.x * 512 + tix_; idx < (size_t)T * 512; idx += (size_t)gridDim.x * 512) {
        const int c = (int)(idx & 511); const int t = (int)(idx >> 9); const int pos = t & (S - 1);
        const int w = 2 << (c >> 7);
        const int cnt = pos + 1 < w ? pos + 1 : w;
        float s = 0.f;
        for (int i = 0; i < cnt; ++i) s += (float)u[(size_t)(t - i) * 512 + c];
        pooled[idx] = (h16)(s / (float)cnt - (float)u[idx]);
    }
}

__device__ __forceinline__ float block_max(float v, float* red) {
#pragma unroll
    for (int o = 1; o < 64; o <<= 1) v = fmaxf(v, __shfl_xor(v, o));
    __syncthreads();
    if ((threadIdx.x & 63) == 0) red[threadIdx.x >> 6] = v;
    __syncthreads();
    return fmaxf(fmaxf(fmaxf(red[0], red[1]), fmaxf(red[2], red[3])), fmaxf(fmaxf(red[4], red[5]), fmaxf(red[6], red[7])));
}
__device__ __forceinline__ float block_sum(float v, float* red) {
    v = wave_sum(v);
    __syncthreads();
    if ((threadIdx.x & 63) == 0) red[threadIdx.x >> 6] = v;
    __syncthreads();
    return ((red[0] + red[1]) + (red[2] + red[3])) + ((red[4] + red[5]) + (red[6] + red[7]));
}
__device__ __forceinline__ int block_sum_i(int v, int* red) {
#pragma unroll
    for (int o = 1; o < 64; o <<= 1) v += __shfl_xor(v, o);
    __syncthreads();
    if ((threadIdx.x & 63) == 0) red[threadIdx.x >> 6] = v;
    __syncthreads();
    return ((red[0] + red[1]) + (red[2] + red[3])) + ((red[4] + red[5]) + (red[6] + red[7]));
}
__device__ __forceinline__ int block_exscan(int v, int* red, int* tot) {
    const int lane = threadIdx.x & 63, w = threadIdx.x >> 6;
    int inc = v;
#pragma unroll
    for (int o = 1; o < 64; o <<= 1) { int t = __shfl_up(inc, o); if (lane >= o) inc += t; }
    __syncthreads();
    if (lane == 63) red[w] = inc;
    __syncthreads();
    int base = 0, all = 0;
#pragma unroll
    for (int i = 0; i < 8; ++i) { const int r = red[i]; if (i < w) base += r; all += r; }
    *tot = all;
    return base + inc - v;
}

__device__ __forceinline__ void ph_memattn(const h16* mq, const h16* __restrict__ mkv, const h16* __restrict__ mz, h16* ymem, float* sm) {
    const int tix_ = opaque_tid();
    float* sq = sm; float* sp = sm + 512; float* red = sm + 1024;
    const int tid = tix_, hh = tid >> 8, j = tid & 255;
    for (int t = blockIdx.x; t < T; t += gridDim.x) {
        const int b = t / S;
        __syncthreads();
        sq[tid] = (float)mq[(size_t)t * 512 + tid];
        __syncthreads();
        for (int hp = 0; hp < 2; ++hp) {
            const int h = hp * 2 + hh;
            const h16* kr = mkv + (size_t)(b * 256 + j) * 1024 + h * 128;
            float s = 0.f;
            for (int d = 0; d < 128; ++d) s += sq[h * 128 + d] * (float)kr[d];
            s *= MEM_SCALE;
            float mx = s;
#pragma unroll
            for (int o = 1; o < 64; o <<= 1) mx = fmaxf(mx, __shfl_xor(mx, o));
            __syncthreads();
            if ((tid & 63) == 0) red[tid >> 6] = mx;
            __syncthreads();
            mx = fmaxf(fmaxf(red[hh * 4], red[hh * 4 + 1]), fmaxf(red[hh * 4 + 2], red[hh * 4 + 3]));
            const float p = __expf(s - mx);
            float sum = wave_sum(p);
            __syncthreads();
            if ((tid & 63) == 0) red[tid >> 6] = sum;
            sp[hh * 256 + j] = p;
            __syncthreads();
            sum = (red[hh * 4] + red[hh * 4 + 1]) + (red[hh * 4 + 2] + red[hh * 4 + 3]);
            if (j < 128) {
                float o = 0.f;
                for (int jj = 0; jj < 256; ++jj) o += sp[hh * 256 + jj] * (float)mkv[(size_t)(b * 256 + jj) * 1024 + 512 + h * 128 + j];
                o /= sum;
                const float z = (float)mz[(size_t)t * 512 + h * 128 + j];
                ymem[(size_t)t * 512 + h * 128 + j] = (h16)(o * silu_f(z));
            }
            __syncthreads();
        }
    }
}

__device__ __forceinline__ unsigned okey(float f) { const unsigned u = __float_as_uint(f); return (u & 0x80000000u) ? ~u : (u | 0x80000000u); }
__device__ __forceinline__ void ph_dsa(const h16* aq, const h16* __restrict__ ak, const h16* __restrict__ av, const h16* __restrict__ az, const h16* __restrict__ iq,
                                       const h16* __restrict__ ik, const float* __restrict__ iw, const float* __restrict__ btab, h16* yattn, unsigned* sm) {
    const int tix_ = opaque_tid();
    unsigned* sc = sm;
    float* siq = (float*)(sm + 8192);
    float* sqa = siq + 512;
    float* sw = sqa + 512;
    float* spsum = sw + 8;
    float* red = spsum + 8;
    int* redi = (int*)(red + 8);
    int* sel = redi + 8;
    float* lg = (float*)(sel + 256);
    const int tid = tix_;
    for (int t = blockIdx.x; t < T; t += gridDim.x) {
        const int b = t / S, pos = t % S, L = (pos / 64 + 1) * 64;
        __syncthreads();
        siq[tid] = (float)iq[(size_t)t * 512 + tid];
        sqa[tid] = (float)aq[(size_t)t * 512 + tid];
        if (tid < 8) sw[tid] = iw[(size_t)t * 8 + tid];
        __syncthreads();
        int nsel;
        if (L <= 256) {
            if (tid < L) sel[tid] = tid;
            nsel = L;
            __syncthreads();
        } else {
            const int chunk = (L + 511) / 512;
            const int s0 = min(L, tid * chunk), s1 = min(L, s0 + chunk);
            for (int s = s0; s < s1; ++s) {
                const h16* kr = ik + (size_t)(b * S + s) * 64;
                float I = 0.f;
                for (int h = 0; h < 8; ++h) {
                    float d = 0.f;
#pragma unroll 8
                    for (int e = 0; e < 64; ++e) d += siq[h * 64 + e] * (float)kr[e];
                    I += sw[h] * fmaxf(d, 0.f);
                }
                sc[s] = okey(I);
            }
            __syncthreads();
            unsigned prefix = 0u;
            for (int bit = 31; bit >= 0; --bit) {
                const unsigned cand = prefix | (1u << bit);
                int c = 0;
                for (int s = s0; s < s1; ++s) c += (sc[s] >= cand) ? 1 : 0;
                c = block_sum_i(c, redi);
                if (c >= 256) prefix = cand;
            }
            int cg_ = 0, ce = 0;
            for (int s = s0; s < s1; ++s) { cg_ += (sc[s] > prefix) ? 1 : 0; ce += (sc[s] == prefix) ? 1 : 0; }
            const int cgt = block_sum_i(cg_, redi);
            const int r = 256 - cgt;
            int tot;
            const int tie_before = block_exscan(ce, redi, &tot);
            int myc = 0; int tb = tie_before;
            for (int s = s0; s < s1; ++s) { const unsigned k = sc[s]; if (k > prefix) ++myc; else if (k == prefix) { if (tb < r) ++myc; ++tb; } }
            int tot2;
            int p = block_exscan(myc, redi, &tot2);
            tb = tie_before;
            for (int s = s0; s < s1; ++s) { const unsigned k = sc[s]; bool take = false; if (k > prefix) take = true; else if (k == prefix) { take = tb < r; ++tb; } if (take) sel[p++] = s; }
            nsel = tot2;
            __syncthreads();
        }
        if (tid < nsel) {
            const int s = sel[tid];
            const h16* kr = ak + (size_t)(b * S + s) * 512;
            for (int h = 0; h < 8; ++h) {
                float d = 0.f;
#pragma unroll 8
                for (int e = 0; e < 64; ++e) d += sqa[h * 64 + e] * (float)kr[h * 64 + e];
                lg[h * 256 + tid] = d * ATTN_SCALE + btab[h * BT_STRIDE + (s - pos + 8191)];
            }
        }
        __syncthreads();
        for (int h = 0; h < 8; ++h) {
            const float v = tid < nsel ? lg[h * 256 + tid] : -INFINITY;
            const float mx = block_max(v, red);
            const float p = tid < nsel ? __expf(v - mx) : 0.f;
            const float ps = block_sum(p, red);
            if (tid == 0) spsum[h] = ps;
            if (tid < nsel) lg[h * 256 + tid] = p;
        }
        __syncthreads();
        {
            const int o = tid, h = o >> 6;
            float acc = 0.f;
            for (int j = 0; j < nsel; ++j) acc += lg[h * 256 + j] * (float)av[(size_t)(b * S + sel[j]) * 512 + o];
            acc /= spsum[h];
            const float z = (float)az[(size_t)t * 512 + o];
            yattn[(size_t)t * 512 + o] = (h16)(acc * silu_f(z));
        }
    }
}


namespace pe {
typedef __attribute__((address_space(3))) unsigned lu32;
typedef __attribute__((address_space(3))) float lf32;
typedef __attribute__((address_space(3))) unsigned char lu8;
typedef unsigned u32x4 __attribute__((ext_vector_type(4)));
typedef float f32x16 __attribute__((ext_vector_type(16)));
constexpr int CAP = 512, TRIG = 448, TOPK = 256;
constexpr int L_LIST = 0;
constexpr int L_MASK = 0, MASK_STRIDE = 257;
constexpr int L_CNT = CAP * 64 * 4;
constexpr int L_TAU = L_CNT + 256;
constexpr int L_HIST = L_TAU + 256;
constexpr int L_FLAG = L_HIST + 8 * 1024;
constexpr int L_END = L_FLAG + 64;
static_assert(MASK_STRIDE * 64 * 4 <= L_CNT, "mask fits under the control words");

__device__ __forceinline__ unsigned okey(float f) { const unsigned u = __float_as_uint(f); return (u & 0x80000000u) ? ~u : (u | 0x80000000u); }
__device__ __forceinline__ float unokey(unsigned k) { return __uint_as_float((k & 0x80000000u) ? (k & 0x7fffffffu) : ~k); }
#define PE_LWAIT() asm volatile("s_waitcnt lgkmcnt(0)" ::: "memory")

__device__ __forceinline__ void score_tile(const h16x8 (&ak)[2][2], const h16x8 (&bq)[8][2], const float (&w)[8], f32x4& I0, f32x4& I1) {
    I0 = (f32x4){0.f, 0.f, 0.f, 0.f}; I1 = I0;
#pragma unroll
    for (int h = 0; h < 8; ++h) {
        f32x4 a0 = (f32x4){0.f, 0.f, 0.f, 0.f}, a1 = a0;
        a0 = __builtin_amdgcn_mfma_f32_16x16x32_f16(ak[0][0], bq[h][0], a0, 0, 0, 0);
        a1 = __builtin_amdgcn_mfma_f32_16x16x32_f16(ak[1][0], bq[h][0], a1, 0, 0, 0);
        a0 = __builtin_amdgcn_mfma_f32_16x16x32_f16(ak[0][1], bq[h][1], a0, 0, 0, 0);
        a1 = __builtin_amdgcn_mfma_f32_16x16x32_f16(ak[1][1], bq[h][1], a1, 0, 0, 0);
#pragma unroll
        for (int r = 0; r < 4; ++r) { I0[r] = fmaf(w[h], fmaxf(a0[r], 0.f), I0[r]); I1[r] = fmaf(w[h], fmaxf(a1[r], 0.f), I1[r]); }
    }
}
__device__ __forceinline__ void load_ik(h16x8 (&ak)[2][2], const h16* IK, size_t key0, int q, int q4) {
#pragma unroll
    for (int kb = 0; kb < 2; ++kb)
#pragma unroll
        for (int ks = 0; ks < 2; ++ks) ak[kb][ks] = *(const h16x8*)(IK + (key0 + 16 * kb + q) * 64 + ks * 32 + q4 * 8);
}
__device__ __forceinline__ void compact(lu32* list, lu32* cntp, lf32* taup, lu32* hist, int lane) {
    const int N = __builtin_amdgcn_readfirstlane((int)*cntp);
    unsigned key[8];
#pragma unroll
    for (int i = 0; i < 8; ++i) { const int idx = lane + 64 * i; key[i] = idx < N ? list[idx] : 0u; }
    unsigned prefix = 0u, mask = 0u; int need = TOPK;
#pragma unroll 1
    for (int pass = 0; pass < 4; ++pass) {
        const int shift = 24 - 8 * pass;
        *(__attribute__((address_space(3))) u32x4*)(hist + 4 * lane) = (u32x4){0u, 0u, 0u, 0u};
        PE_LWAIT();
#pragma unroll
        for (int i = 0; i < 8; ++i) if ((key[i] & mask) == prefix) __hip_atomic_fetch_add(hist + ((key[i] >> shift) & 255u), 1u, __ATOMIC_RELAXED, __HIP_MEMORY_SCOPE_WORKGROUP);
        PE_LWAIT();
        const u32x4 b4 = *(const __attribute__((address_space(3))) u32x4*)(hist + 4 * (63 - lane));
        const int s = (int)(b4[0] + b4[1] + b4[2] + b4[3]);
        int incl = s;
#pragma unroll
        for (int o = 1; o < 64; o <<= 1) { const int t = __shfl_up(incl, o); if (lane >= o) incl += t; }
        const unsigned long long bal = __ballot(incl >= need);
        const int Ls = __builtin_amdgcn_readfirstlane((int)__builtin_ctzll(bal));
        int e = incl - s, d = 255 - 4 * lane, dstar = 0, rank = 0; bool found = false;
#pragma unroll
        for (int j = 3; j >= 0; --j) { const int bb = (int)b4[j]; if (!found) { if (e + bb >= need) { found = true; dstar = d; rank = need - e; } else { e += bb; --d; } } }
        dstar = __builtin_amdgcn_readlane(dstar, Ls); rank = __builtin_amdgcn_readlane(rank, Ls);
        prefix |= (unsigned)dstar << shift; mask |= 255u << shift; need = rank;
        PE_LWAIT();
    }
    int pos = 0;
#pragma unroll
    for (int i = 0; i < 8; ++i) {
        const bool f = key[i] > prefix;
        const unsigned long long bal = __ballot(f);
        const int off = __builtin_popcountll(bal & ((1ull << lane) - 1ull));
        if (f) list[pos + off] = key[i];
        pos += __builtin_popcountll(bal);
    }
    for (int k = lane; k < need; k += 64) list[pos + k] = prefix;
    if (lane == 0) { *cntp = (unsigned)TOPK; *taup = unokey(prefix); }
    PE_LWAIT();
}

struct Tens { const h16 *IQ, *IK, *AQ, *AZ, *KF, *VF; const float *IW, *BTAB; const int* BKT; h16* Y; float* TAU; };

__device__ __forceinline__ void unit(const Tens& X, int b, int c, lu8* lds, int tid_) {
    int tid = tid_; asm volatile("" : "+v"(tid));
    int lane = tid & 63; const int w = __builtin_amdgcn_readfirstlane(tid >> 6);
    lu32* LIST = (lu32*)(lds + L_LIST); lu32* CNT = (lu32*)(lds + L_CNT); lf32* TAU = (lf32*)(lds + L_TAU);
    lu32* HIST = (lu32*)(lds + L_HIST) + 256 * w; lu32* FLAG = (lu32*)(lds + L_FLAG); lu32* MASK = (lu32*)(lds + L_MASK);
    const size_t tok0 = (size_t)b * S + 64 * c;
    const size_t kbase = (size_t)b * S;
    const int ntile = c + 1;
    {
        const int qg = w & 3, kh = w >> 2, q = lane & 15, q4 = lane >> 4, ql = 16 * qg + q;
        const size_t tq = tok0 + ql;
        h16x8 bq[8][2]; float wv[8];
#pragma unroll
        for (int h = 0; h < 8; ++h)
#pragma unroll
            for (int ks = 0; ks < 2; ++ks) bq[h][ks] = *(const h16x8*)(X.IQ + tq * 512 + h * 64 + ks * 32 + q4 * 8);
        { const f32x4 w0 = *(const f32x4*)(X.IW + tq * 8), w1 = *(const f32x4*)(X.IW + tq * 8 + 4);
#pragma unroll
          for (int e = 0; e < 4; ++e) { wv[e] = w0[e]; wv[4 + e] = w1[e]; } }
        if (tid < 64) { CNT[tid] = 0u; TAU[tid] = -INFINITY; }
        if (tid < 4) FLAG[tid] = 0u;
        __syncthreads();
        if (c >= 4) {
            h16x8 akc[2][2], akn[2][2];
            load_ik(akc, X.IK, kbase + 32 * kh, q, q4);
#pragma unroll 1
            for (int j = 0; j < ntile; ++j) {
                if (j + 1 < ntile) load_ik(akn, X.IK, kbase + 64 * (j + 1) + 32 * kh, q, q4);
                f32x4 I0, I1; score_tile(akc, bq, wv, I0, I1);
                const float tau = TAU[ql];
                unsigned f = 0u;
#pragma unroll
                for (int r = 0; r < 4; ++r) { f |= (I0[r] > tau ? 1u : 0u) << r; f |= (I1[r] > tau ? 1u : 0u) << (4 + r); }
                const int nc = __builtin_popcount(f);
                const int slot = j % 3;
                if (nc) {
                    unsigned base = __hip_atomic_fetch_add(CNT + ql, (unsigned)nc, __ATOMIC_RELAXED, __HIP_MEMORY_SCOPE_WORKGROUP);
                    lu32* lp = LIST + ql * CAP;
#pragma unroll
                    for (int r = 0; r < 4; ++r) if (f & (1u << r)) lp[base++] = okey(I0[r]);
#pragma unroll
                    for (int r = 0; r < 4; ++r) if (f & (16u << r)) lp[base++] = okey(I1[r]);
                    if (base > (unsigned)TRIG) FLAG[slot] = 1u;
                }
                __syncthreads();
                const unsigned fl = FLAG[slot];
                if (tid == 0) FLAG[(j + 2) % 3] = 0u;
                if (fl) {
#pragma unroll 1
                    for (int i = 0; i < 8; ++i) { const int qq = 8 * w + i; if ((int)CNT[qq] > TRIG) compact(LIST + qq * CAP, CNT + qq, TAU + qq, HIST, lane); }
                    __syncthreads();
                }
#pragma unroll
                for (int kb = 0; kb < 2; ++kb)
#pragma unroll
                    for (int ks = 0; ks < 2; ++ks) akc[kb][ks] = akn[kb][ks];
            }
#pragma unroll 1
            for (int i = 0; i < 8; ++i) { const int qq = 8 * w + i; if ((int)CNT[qq] > TOPK) compact(LIST + qq * CAP, CNT + qq, TAU + qq, HIST, lane); }
            __syncthreads();
        }
        if (X.TAU && tid < 64) X.TAU[tok0 + tid] = TAU[tid];
        for (int i = tid; i < 64 * MASK_STRIDE; i += 512) MASK[i] = 0u;
        __syncthreads();
        {
            const float tau = TAU[ql];
            h16x8 akc[2][2], akn[2][2];
            load_ik(akc, X.IK, kbase + 32 * kh, q, q4);
#pragma unroll 1
            for (int j = 0; j < ntile; ++j) {
                if (j + 1 < ntile) load_ik(akn, X.IK, kbase + 64 * (j + 1) + 32 * kh, q, q4);
                f32x4 I0, I1; score_tile(akc, bq, wv, I0, I1);
                unsigned n0 = 0u, n1 = 0u;
#pragma unroll
                for (int r = 0; r < 4; ++r) { n0 |= (I0[r] >= tau ? 1u : 0u) << r; n1 |= (I1[r] >= tau ? 1u : 0u) << r; }
                const unsigned bits = (n0 << (4 * q4)) | (n1 << (16 + 4 * q4));
                __hip_atomic_fetch_or(MASK + ql * MASK_STRIDE + 2 * j + kh, bits, __ATOMIC_RELAXED, __HIP_MEMORY_SCOPE_WORKGROUP);
#pragma unroll
                for (int kb = 0; kb < 2; ++kb)
#pragma unroll
                    for (int ks = 0; ks < 2; ++ks) akc[kb][ks] = akn[kb][ks];
            }
        }
        __syncthreads();
    }
    {
        asm volatile("" : "+v"(lane));
        const int h = w, r32 = lane & 31, hh = lane >> 5;
        h16x8 bqf[2][4];
#pragma unroll
        for (int qb = 0; qb < 2; ++qb)
#pragma unroll
            for (int ks = 0; ks < 4; ++ks) bqf[qb][ks] = *(const h16x8*)(X.AQ + (tok0 + 32 * qb + r32) * 512 + h * 64 + 16 * ks + 8 * hh);
        f32x16 O[2][2]; float mrun[2], lrun[2];
#pragma unroll
        for (int qb = 0; qb < 2; ++qb) { mrun[qb] = -INFINITY; lrun[qb] = 0.f;
#pragma unroll
            for (int db = 0; db < 2; ++db)
#pragma unroll
                for (int e = 0; e < 16; ++e) O[qb][db][e] = 0.f; }
        const h16* kfp = X.KF + ((size_t)(b * 8 + h) * 256) * 2048 + (size_t)lane * 8;
        const h16* vfp = X.VF + ((size_t)(b * 8 + h) * 256) * 2048 + (size_t)lane * 8;
        const int nstep = 2 * ntile;
        const int qpos0 = 64 * c;
        h16x8 kf[4], vf[4], kfn[4], vfn[4];
#pragma unroll
        for (int i = 0; i < 4; ++i) { kf[i] = *(const h16x8*)(kfp + i * 512); vf[i] = *(const h16x8*)(vfp + i * 512); }
#pragma unroll 1
        for (int st = 0; st < nstep; ++st) {
            if (st + 1 < nstep) {
#pragma unroll
                for (int i = 0; i < 4; ++i) { kfn[i] = *(const h16x8*)(kfp + (size_t)(st + 1) * 2048 + i * 512); vfn[i] = *(const h16x8*)(vfp + (size_t)(st + 1) * 2048 + i * 512); }
            }
            const int k0 = 32 * st;
            const int relmin = k0 - (qpos0 + 63), relmax = k0 + 31 - qpos0;
            const bool ubias = (relmax <= 0) && (X.BKT[relmin + 8191] == X.BKT[relmax + 8191]);
            const float bu = X.BTAB[h * BT_STRIDE + relmin + 8191];
#pragma unroll
            for (int qb = 0; qb < 2; ++qb) {
                f32x16 Sx;
#pragma unroll
                for (int e = 0; e < 16; ++e) Sx[e] = 0.f;
#pragma unroll
                for (int ks = 0; ks < 4; ++ks) Sx = __builtin_amdgcn_mfma_f32_32x32x16_f16(kf[ks], bqf[qb][ks], Sx, 0, 0, 0);
                const unsigned word = MASK[(32 * qb + r32) * MASK_STRIDE + st] >> (4 * hh);
                float x[16];
                if (ubias) {
#pragma unroll
                    for (int e = 0; e < 16; ++e) x[e] = fmaf(Sx[e], ATTN_SCALE, bu);
                } else {
                    const float* bt = X.BTAB + h * BT_STRIDE + (k0 + 4 * hh - (qpos0 + 32 * qb + r32) + 8191);
#pragma unroll
                    for (int e = 0; e < 16; ++e) x[e] = fmaf(Sx[e], ATTN_SCALE, bt[(e & 3) + 8 * (e >> 2)]);
                }
                float mx = -INFINITY;
#pragma unroll
                for (int e = 0; e < 16; ++e) { const bool sel = (word >> ((e & 3) + 8 * (e >> 2))) & 1u; x[e] = sel ? x[e] : -INFINITY; mx = fmaxf(mx, x[e]); }
                mx = fmaxf(mx, __shfl_xor(mx, 32));
                const float mnew = fmaxf(mrun[qb], mx);
                const float msafe = (mnew == -INFINITY) ? 0.f : mnew;
                const float alpha = __expf(mrun[qb] - msafe);
                float rs = 0.f;
#pragma unroll
                for (int e = 0; e < 16; ++e) { x[e] = __expf(x[e] - msafe); rs += x[e]; }
                lrun[qb] = lrun[qb] * alpha + rs; mrun[qb] = mnew;
#pragma unroll
                for (int db = 0; db < 2; ++db)
#pragma unroll
                    for (int e = 0; e < 16; ++e) O[qb][db][e] *= alpha;
                h16x8 pf[2];
#pragma unroll
                for (int s2 = 0; s2 < 2; ++s2)
#pragma unroll
                    for (int e = 0; e < 8; ++e) pf[s2][e] = (h16)x[8 * s2 + e];
#pragma unroll
                for (int s2 = 0; s2 < 2; ++s2)
#pragma unroll
                    for (int db = 0; db < 2; ++db) O[qb][db] = __builtin_amdgcn_mfma_f32_32x32x16_f16(vf[s2 * 2 + db], pf[s2], O[qb][db], 0, 0, 0);
            }
#pragma unroll
            for (int i = 0; i < 4; ++i) { kf[i] = kfn[i]; vf[i] = vfn[i]; }
        }
#pragma unroll
        for (int qb = 0; qb < 2; ++qb) {
            const float lt = lrun[qb] + __shfl_xor(lrun[qb], 32);
            const float inv = 1.f / lt;
            const size_t trow = (tok0 + 32 * qb + r32) * 512 + h * 64;
#pragma unroll
            for (int db = 0; db < 2; ++db)
#pragma unroll
                for (int g = 0; g < 4; ++g) {
                    const int d = 32 * db + 8 * g + 4 * hh;
                    const h16x4 z = *(const h16x4*)(X.AZ + trow + d);
                    h16x4 o;
#pragma unroll
                    for (int e = 0; e < 4; ++e) o[e] = (h16)(O[qb][db][4 * g + e] * inv * silu_fast((float)z[e]));
                    *(h16x4*)(X.Y + trow + d) = o;
                }
        }
    }
    __syncthreads();
}

__device__ __forceinline__ void phase(const Tens& X, lu8* lds, int G, int vc) {
    const int tid = opaque_tid();
    const int nun = (G == 256) ? 2 : (512 - vc + G - 1) / G;
#pragma unroll 1
    for (int it = 0; it < nun; ++it) {
        int b, c;
        if (G == 256) { b = vc >> 6; c = it ? (vc & 63) : 127 - (vc & 63); } else { const int u = vc + it * G; b = u >> 7; c = u & 127; }
        unit(X, b, c, lds, tid);
    }
}
}

enum { OP_STORE = 0, OP_IKIW = 1, OP_POOLMIX = 2, OP_GATE = 3, OP_BR0 = 4, OP_BR1 = 5, OP_BR2 = 6, OP_OUT = 7, OP_MKV = 8, OP_KF = 9, OP_VF = 10 };
enum { PH_GEMM1 = 0, PH_POOLMIX = 1, PH_MERGE = 2, PH_OUT = 3 };
constexpr int NXCD = 8, WGM = 8;
struct Bufs {
    char* ws; const float* pool_scale; const float* xin; float* xout; h16* kf; h16* vf;
#define BUF_ACC(name, off, type) __device__ __forceinline__ type* name() const { return (type*)(ws + (off)); }
    BUF_ACC(W1T, WS_W1T, h16) BUF_ACC(WGT, WS_WGT, h16) BUF_ACC(WBT, WS_WBT, h16) BUF_ACC(WOT, WS_WOT, h16) BUF_ACC(WKVT, WS_WKVT, h16) BUF_ACC(PWT, WS_PWT, h16)
    BUF_ACC(MEMN, WS_MEMN, h16) BUF_ACC(MKV, WS_MKV, h16) BUF_ACC(H, WS_H, h16) BUF_ACC(ARR, WS_ARR, h16) BUF_ACC(POOLED, WS_POOLED, h16) BUF_ACC(IK, WS_IK, h16)
    BUF_ACC(MERGED, WS_MERGED, h16) BUF_ACC(GS, WS_BBUF, h16) BUF_ACC(IW, WS_IW, float) BUF_ACC(BT, WS_BIAS, float)
#undef BUF_ACC
};
__device__ __forceinline__ void tile_order(int L, int nM, int nN, int& pm, int& pn) {
    const int nwg = nM * nN;
    int wgid = L; { const int q = nwg / NXCD, r = nwg % NXCD, xcd = wgid % NXCD, off = wgid / NXCD; wgid = (xcd < r ? xcd * (q + 1) : r * (q + 1) + (xcd - r) * q) + off; }
    const int nig = WGM * nN, gid = wgid / nig, fm = gid * WGM, gsz = (nM - fm) < WGM ? (nM - fm) : WGM;
    pm = fm + ((wgid % nig) % gsz); pn = (wgid % nig) / gsz;
}
struct Sched {
    int phase, layer, G, c, vc; Bufs b;
    __device__ __forceinline__ bool next(int i, g8::Unit& u) const {
        const size_t ASZ = (size_t)T * 512;
        if (phase == PH_GEMM1) {
            const int nmain = 128 * 19, L = i * G + c;
            if (L < nmain) {
                int pm, pn; tile_order(L, 128, 19, pm, pn);
                u.A = (const char*)(b.H() + (size_t)pm * 256 * D); u.lda = D;
                u.B = (const char*)(b.W1T() + (size_t)layer * N1 * D + (size_t)pn * 256 * D); u.ldb = D; u.nt = 16; u.pm = pm; u.pn = pn;
                if (pn < 18) {
                    const int a = pn >> 1;
                    const int slot = (a == 0) ? A_POOLU : (a == 1) ? A_POOLZ : (a == 2) ? A_AQ : (a == 3) ? A_AK : (a == 4) ? A_AV : (a == 5) ? A_AZ : (a == 6) ? A_IQ : (a == 7) ? A_MQ : A_MZ;
                    u.op = (a == 3) ? OP_KF : (a == 4) ? OP_VF : OP_STORE; u.aux = slot;
                } else { u.op = OP_IKIW; u.aux = 0; }
                return true;
            }
            if (layer == 0 && L < nmain + 32) {
                const int e = L - nmain, ly = e >> 4, pm = (e & 15) >> 2, pn = e & 3;
                u.A = (const char*)(b.MEMN() + (size_t)ly * 1024 * D + (size_t)pm * 256 * D); u.lda = D;
                u.B = (const char*)(b.WKVT() + (size_t)ly * 1024 * D + (size_t)pn * 256 * D); u.ldb = D; u.nt = 16; u.pm = pm; u.pn = pn;
                u.op = OP_MKV; u.aux = ly;
                return true;
            }
            return false;
        } else if (phase == PH_POOLMIX) {
            const int L = i * G + vc; if (L >= 256) return false;
            const int pm = L >> 1, pn = L & 1;
            u.A = (const char*)(b.POOLED() + (size_t)pm * 256 * 512 + pn * 256); u.lda = 512;
            u.B = (const char*)(b.PWT() + (size_t)layer * 512 * 256 + (size_t)pn * 256 * 256); u.ldb = 256; u.nt = 4; u.pm = pm; u.pn = pn;
            u.op = OP_POOLMIX; u.aux = 0;
            return true;
        } else if (phase == PH_MERGE) {
            const int j = i / 6, sub = i - 6 * j, ot = j * G + vc; if (ot >= 512) return false;
            const int pm = ot >> 2, pn = ot & 3, br = sub >> 1;
            u.pm = pm; u.pn = pn;
            if ((sub & 1) == 0) {
                u.A = (const char*)(b.H() + (size_t)pm * 256 * D); u.lda = D;
                u.B = (const char*)(b.WGT() + (size_t)layer * 3072 * D + (size_t)(br * 1024 + pn * 256) * D); u.ldb = D; u.nt = 16;
                u.op = OP_GATE; u.aux = 0;
            } else {
                const int slot = br == 0 ? A_POOLU : br == 1 ? A_AQ : A_MQ;
                u.A = (const char*)(b.ARR() + (size_t)slot * ASZ + (size_t)pm * 256 * 512); u.lda = 512;
                u.B = (const char*)(b.WBT() + ((size_t)layer * 3 + br) * 1024 * 512 + (size_t)pn * 256 * 512); u.ldb = 512; u.nt = 8;
                u.op = OP_BR0 + br; u.aux = 0;
            }
            return true;
        } else {
            const int ot = i * G + vc; if (ot >= 512) return false;
            const int pm = ot >> 2, pn = ot & 3;
            u.A = (const char*)(b.MERGED() + (size_t)pm * 256 * D); u.lda = D;
            u.B = (const char*)(b.WOT() + (size_t)layer * D * D + (size_t)pn * 256 * D); u.ldb = D; u.nt = 16; u.pm = pm; u.pn = pn;
            u.op = OP_OUT; u.aux = 0;
            return true;
        }
    }
};
__device__ __forceinline__ h16x8 cvt8(const f32x4& a, const f32x4& b) { h16x8 r = {(h16)a[0], (h16)a[1], (h16)a[2], (h16)a[3], (h16)b[0], (h16)b[1], (h16)b[2], (h16)b[3]}; return r; }
struct Epi {
    Bufs b;
#define EPI_LOOP(...) _Pragma("unroll") for (int ai = 0; ai < 2; ++ai) _Pragma("unroll") for (int m = 0; m < 4; ++m) { \
        const int rl = ai * 128 + wr * 64 + m * 16 + fr; const size_t rg = (size_t)u.pm * 256 + rl; (void)rg; \
        _Pragma("unroll") for (int bj = 0; bj < 2; ++bj) { const int cl = bj * 128 + wc * 32 + fq * 8; const int j = (ai * 4 + m) * 2 + bj; (void)j; \
            const f32x4 v0 = acc[ai][bj][m][0], v1 = acc[ai][bj][m][1]; __VA_ARGS__ } asm volatile("" ::: "memory"); }
    __device__ __forceinline__ void operator()(const f32x4 (&acc)[2][2][4][2], const g8::Unit& u, int wr_, int wc_, int fr_, int fq_) const {
        const int tid = opaque_tid();
        const int lane = tid & 63, wid = tid >> 6, wr = wid >> 2, wc = wid & 3, fr = lane & 15, fq = lane >> 4;
        const int op = u.op;
        if (op == OP_STORE) {
            h16* dst = b.ARR() + (size_t)u.aux * ((size_t)T * 512) + (u.pn & 1) * 256;
            EPI_LOOP({ *(h16x8*)(dst + rg * 512 + cl) = cvt8(v0, v1); })
        } else if (op == OP_KF) {
#if PROBE
            { h16* dst = b.ARR() + (size_t)u.aux * ((size_t)T * 512) + (u.pn & 1) * 256; EPI_LOOP({ *(h16x8*)(dst + rg * 512 + cl) = cvt8(v0, v1); }) }
#endif
            EPI_LOOP({
                const int bb = (int)(rg >> 13), sp = (int)(rg & 8191), cc = (u.pn & 1) * 256 + cl, hd = cc >> 6, d = cc & 63;
                const size_t off = ((((size_t)(bb * 8 + hd) * 256 + (sp >> 5)) * 4 + (d >> 4)) * 64 + ((sp & 31) + 32 * ((d >> 3) & 1))) * 8;
                *(h16x8*)(b.kf + off) = cvt8(v0, v1); })
        } else if (op == OP_VF) {
#if PROBE
            { h16* dst = b.ARR() + (size_t)u.aux * ((size_t)T * 512) + (u.pn & 1) * 256; EPI_LOOP({ *(h16x8*)(dst + rg * 512 + cl) = cvt8(v0, v1); }) }
#endif
            EPI_LOOP({
                const int bb = (int)(rg >> 13), sp = (int)(rg & 8191), cc = (u.pn & 1) * 256 + cl, hd = cc >> 6, d0 = cc & 63;
                const int kk = sp & 31, s2 = kk >> 4, k16 = kk & 15, hh = (k16 >> 2) & 1, jj = ((k16 >> 3) << 2) | (k16 & 3);
                h16* dst = b.vf + ((((((size_t)(bb * 8 + hd) * 256 + (sp >> 5)) * 2 + s2) * 2 + (d0 >> 5)) * 64 + ((d0 & 31) + 32 * hh)) * 8 + jj);
                const h16x8 hv = cvt8(v0, v1);
                _Pragma("unroll") for (int e = 0; e < 8; ++e) dst[e * 8] = hv[e]; })
        } else if (op == OP_MKV) {
            h16* dst = b.MKV() + (size_t)u.aux * 1024 * 1024 + u.pn * 256;
            EPI_LOOP({ *(h16x8*)(dst + rg * 1024 + cl) = cvt8(v0, v1); })
        } else if (op == OP_IKIW) {
            EPI_LOOP({ if (bj == 0) {
                if (wc < 2) *(h16x8*)(b.IK() + rg * 64 + cl) = cvt8(v0, v1);
                else if (wc == 2 && fq == 0) { *(f32x4*)(b.IW() + rg * 8) = v0 * IDX_W_SCALE; *(f32x4*)(b.IW() + rg * 8 + 4) = v1 * IDX_W_SCALE; } } })
        } else if (op == OP_POOLMIX) {
            EPI_LOOP({
                const int cg_ = u.pn * 256 + cl;
                const h16x8 z = *(const h16x8*)(b.ARR() + (size_t)A_POOLZ * ((size_t)T * 512) + rg * 512 + cg_);
                const f32x4 s0 = *(const f32x4*)(b.pool_scale + cg_), s1 = *(const f32x4*)(b.pool_scale + cg_ + 4);
                f32x4 y0, y1;
                _Pragma("unroll") for (int e = 0; e < 4; ++e) { y0[e] = v0[e] * s0[e] * silu_fast((float)z[e]); y1[e] = v1[e] * s1[e] * silu_fast((float)z[4 + e]); }
                *(h16x8*)(b.ARR() + (size_t)A_POOLU * ((size_t)T * 512) + rg * 512 + cg_) = cvt8(y0, y1); })
        } else if (op == OP_GATE) {
            EPI_LOOP({
                f32x4 g0, g1;
                _Pragma("unroll") for (int e = 0; e < 4; ++e) { g0[e] = sigm_fast(v0[e]); g1[e] = sigm_fast(v1[e]); }
                *(h16x8*)(b.GS() + ((size_t)blockIdx.x * 16 * 512 + (size_t)j * 512 + tid) * 8) = cvt8(g0, g1); })
        } else if (op == OP_OUT) {
            EPI_LOOP({
                const size_t o = rg * 1024 + u.pn * 256 + cl;
                const f32x4 x0 = *(const f32x4*)(b.xin + o), x1 = *(const f32x4*)(b.xin + o + 4);
                *(f32x4*)(b.xout + o) = x0 + v0; *(f32x4*)(b.xout + o + 4) = x1 + v1; })
        } else {
            const bool first = (op == OP_BR0);
            EPI_LOOP({
                const h16x8 g = *(const h16x8*)(b.GS() + ((size_t)blockIdx.x * 16 * 512 + (size_t)j * 512 + tid) * 8);
                f32x4 y0, y1;
                _Pragma("unroll") for (int e = 0; e < 4; ++e) { y0[e] = (float)g[e] * v0[e]; y1[e] = (float)g[4 + e] * v1[e]; }
                h16x8* mp = (h16x8*)(b.MERGED() + rg * 1024 + u.pn * 256 + cl);
                if (!first) { const h16x8 mo = *mp;
                    _Pragma("unroll") for (int e = 0; e < 4; ++e) { y0[e] += (float)mo[e]; y1[e] += (float)mo[4 + e]; } }
                *mp = cvt8(y0, y1); })
        }
    }
#undef EPI_LOOP
};
struct Params {
    const float *x, *mem, *norm_g, *w_in, *pool_w, *pool_scale, *mem_norm_g, *w_mem_kv, *w_branch, *w_out, *rel_bias, *final_g;
    float* out; char* ws;
};
constexpr int NT = 512;
constexpr int LDS_BYTES = 144 * 1024;

__global__ void __launch_bounds__(NT, 2) mega(Params p) {
    cg::grid_group grid = cg::this_grid();
    extern __shared__ __attribute__((aligned(16))) unsigned char smem[];
    char* ws = p.ws; float* out = p.out;
    Bufs b; b.ws = ws; b.pool_scale = p.pool_scale; b.xin = p.x; b.xout = out;
#if PROBE
    b.kf = (h16*)out; b.vf = (h16*)out + (size_t)T * 512;
#else
    b.kf = (h16*)(ws + WS_ARR) + (size_t)A_AK * ((size_t)T * 512); b.vf = (h16*)(ws + WS_ARR) + (size_t)A_AV * ((size_t)T * 512);
#endif
    const size_t ASZ = (size_t)T * 512;
    const int G = gridDim.x, bx = blockIdx.x, vc = (G % 8 == 0) ? (bx % 8) * (G / 8) + bx / 8 : bx;
    g8::G8_LAS_T lds = (g8::G8_LAS_T)smem;
#if PROBE
    {
        float* diag = (float*)(ws + WS_DIAG);
#pragma unroll 1
        for (int step = 0; step < 7; ++step) {
            { char* w_ = p.ws; asm volatile("" : "+s"(w_)); b.ws = w_; }
            float* BT = b.BT(); h16* ARR = b.ARR();
            h16* YF = b.POOLED();
            if (step == 0) {
                if (blockIdx.x == 0 && threadIdx.x < 4) diag[threadIdx.x] = 0.f;
                ph_convert_w(p.w_in, IN_COLS, D, b.W1T(), D, N1, 1, 0, (float*)smem);
                for (int ll = 0; ll < 2; ++ll) {
                    ph_convert_w(p.w_mem_kv + (size_t)ll * D * 1024, 1024, D, b.WKVT() + (size_t)ll * 1024 * D, D, 1024, 0, 0, (float*)smem);
                    ph_rmsnorm<false>(p.mem, p.mem_norm_g + (size_t)ll * D, (void*)(b.MEMN() + (size_t)ll * 1024 * D), 1024);
                }
                ph_bias_tab(p.rel_bias, BT, (int*)(b.ws + WS_BKT));
                ph_rmsnorm<false>(p.x, p.norm_g, (void*)b.H(), T);
            } else if (step == 1) {
                Sched s{PH_GEMM1, 0, G, bx, vc, b}; Epi e{b}; g8::gemm_phase(lds, s, e);
            } else if (step == 2) {
                pe::Tens X{ARR + A_IQ * ASZ, b.IK(), ARR + A_AQ * ASZ, ARR + A_AZ * ASZ, b.kf, b.vf, b.IW(), BT, (const int*)(b.ws + WS_BKT), YF, nullptr};
                pe::phase(X, (pe::lu8*)smem, G, vc);
            } else if (step == 3) {
                ph_dsa(ARR + A_AQ * ASZ, ARR + A_AK * ASZ, ARR + A_AV * ASZ, ARR + A_AZ * ASZ, ARR + A_IQ * ASZ, b.IK(), b.IW(), BT, ARR + A_AQ * ASZ, (unsigned*)smem);
            } else if (step == 4) {
                const h16* YN = ARR + A_AQ * ASZ; float sd = 0.f, sn = 0.f;
                for (size_t i = (size_t)blockIdx.x * 512 + threadIdx.x; i < ASZ; i += (size_t)gridDim.x * 512) { const float a = (float)YF[i], c = (float)YN[i]; sd += (a - c) * (a - c); sn += c * c; }
                sd = wave_sum(sd); sn = wave_sum(sn);
                if ((threadIdx.x & 63) == 0) { atomicAdd(diag, sd); atomicAdd(diag + 1, sn); }
            } else if (step == 5) {
                const float msd = diag[0] / fmaxf(diag[1], 1e-30f);
                const float val = 100.f * (10.f + log10f(fmaxf(msd, 1e-9f)));
                for (size_t i = (size_t)blockIdx.x * 512 + threadIdx.x; i < (size_t)T * D; i += (size_t)gridDim.x * 512) out[i] = val;
            }
            if (step < 6) grid.sync();
        }
    }
}

#else
    constexpr int NSTEPS = 2 + 6 * DEPTH;
#pragma unroll 1
    for (int step = 0; step < NSTEPS; ++step) {
        const int l = (step - 1) / 6, k = (step - 1) - 6 * l;
        { char* w_ = p.ws; asm volatile("" : "+s"(w_)); b.ws = w_; }
        float* BT = b.BT(); h16* ARR = b.ARR();
        if (step == 0) {
            for (int ll = 0; ll < DEPTH; ++ll) {
                ph_convert_w(p.w_in + (size_t)ll * D * IN_COLS, IN_COLS, D, b.W1T() + (size_t)ll * N1 * D, D, N1, 1, 0, (float*)smem);
                ph_convert_w(p.w_in + (size_t)ll * D * IN_COLS, IN_COLS, D, b.WGT() + (size_t)ll * 3072 * D, D, 3072, 0, 4680, (float*)smem);
                for (int i = 0; i < 3; ++i) ph_convert_w(p.w_branch + ((size_t)ll * 3 + i) * 512 * 1024, 1024, 512, b.WBT() + ((size_t)ll * 3 + i) * 1024 * 512, 512, 1024, 0, 0, (float*)smem);
                ph_convert_w(p.w_out + (size_t)ll * D * D, D, D, b.WOT() + (size_t)ll * D * D, D, D, 0, 0, (float*)smem);
                ph_convert_w(p.w_mem_kv + (size_t)ll * D * 1024, 1024, D, b.WKVT() + (size_t)ll * 1024 * D, D, 1024, 0, 0, (float*)smem);
                ph_convert_pw(p.pool_w + (size_t)ll * 4 * 128 * 128, b.PWT() + (size_t)ll * 512 * 256);
                ph_rmsnorm<false>(p.mem, p.mem_norm_g + (size_t)ll * D, (void*)(b.MEMN() + (size_t)ll * 1024 * D), 1024);
            }
            ph_bias_tab(p.rel_bias, BT, (int*)(b.ws + WS_BKT));
        } else if (step == NSTEPS - 1) {
            ph_rmsnorm<true>((const float*)out, p.final_g, (void*)out, T);
        } else {
            b.xin = l == 0 ? p.x : (const float*)out; b.pool_scale = p.pool_scale + (size_t)l * 512;
            if (k == 0) {
                ph_rmsnorm<false>(b.xin, p.norm_g + (size_t)l * D, (void*)b.H(), T);
            } else if (k == 2) {
                ph_pooled(ARR + A_POOLU * ASZ, b.POOLED());
                ph_memattn(ARR + A_MQ * ASZ, b.MKV() + (size_t)l * 1024 * 1024, ARR + A_MZ * ASZ, ARR + A_MQ * ASZ, (float*)smem);
                pe::Tens X{ARR + A_IQ * ASZ, b.IK(), ARR + A_AQ * ASZ, ARR + A_AZ * ASZ, b.kf, b.vf, b.IW(), BT, (const int*)(b.ws + WS_BKT), ARR + A_AQ * ASZ, nullptr};
                pe::phase(X, (pe::lu8*)smem, G, vc);
            } else {
                const int ph = k == 1 ? PH_GEMM1 : k == 3 ? PH_POOLMIX : k == 4 ? PH_MERGE : PH_OUT;
                Sched s{ph, l, G, bx, vc, b}; Epi e{b}; g8::gemm_phase(lds, s, e);
            }
        }
        if (step < NSTEPS - 1) grid.sync();
    }
}

#endif
extern "C" void kernel_launch(void* const* d_in, const int* in_sizes, int n_in, void* d_out, int out_size, void* d_ws, size_t ws_size, hipStream_t stream) {
    static int grid_blocks = 0;
    if (!grid_blocks) {
        int dev = 0, cus = 0, per_cu = 0;
        (void)hipGetDevice(&dev);
        (void)hipDeviceGetAttribute(&cus, hipDeviceAttributeMultiprocessorCount, dev);
        (void)hipFuncSetAttribute((const void*)mega, hipFuncAttributeMaxDynamicSharedMemorySize, LDS_BYTES);
        (void)hipOccupancyMaxActiveBlocksPerMultiprocessor(&per_cu, mega, NT, LDS_BYTES);
        if (per_cu < 1) per_cu = 1;
        grid_blocks = cus * 1;
    }
    Params p{};
    p.x = (const float*)d_in[0]; p.mem = (const float*)d_in[1]; p.norm_g = (const float*)d_in[2]; p.w_in = (const float*)d_in[3];
    p.pool_w = (const float*)d_in[4]; p.pool_scale = (const float*)d_in[5]; p.mem_norm_g = (const float*)d_in[6]; p.w_mem_kv = (const float*)d_in[7];
    p.w_branch = (const float*)d_in[8]; p.w_out = (const float*)d_in[9]; p.rel_bias = (const float*)d_in[10]; p.final_g = (const float*)d_in[11];
    p.out = (float*)d_out; p.ws = (char*)d_ws;
    void* args[] = {&p};
    hipError_t e = hipLaunchCooperativeKernel((void*)mega, dim3(grid_blocks), dim3(NT), args, LDS_BYTES, stream);
    if (e != hipSuccess) fprintf(stderr, "cooperative launch failed: %s (grid %d)\n", hipGetErrorString(e), grid_blocks);
}
```

```cpp
#ifndef PROBE
#define PROBE 0
#endif
#include <hip/hip_runtime.h>
#include <hip/hip_cooperative_groups.h>
#include <stdio.h>
namespace cg = cooperative_groups;
#include <stdint.h>
#include <math.h>

typedef _Float16 h16;
typedef _Float16 h16x8 __attribute__((ext_vector_type(8)));
typedef float f32x4 __attribute__((ext_vector_type(4)));
typedef _Float16 h16x4 __attribute__((ext_vector_type(4)));

constexpr int Bn = 4, S = 8192, T = Bn * S, D = 1024, DEPTH = 2;
constexpr int IN_COLS = 7752;
constexpr int N1 = 4864;
constexpr float EPS = 1e-6f;
constexpr float IDX_W_SCALE = 0.125f * 0.35355339059327373f;
constexpr float ATTN_SCALE = 0.125f;
constexpr float MEM_SCALE = 0.08838834764831845f;
constexpr int BT_STRIDE = 8256;

constexpr size_t MiB = 1u << 20;
constexpr size_t WS_W1T = 1 * MiB;
constexpr size_t WS_WGT = 20 * MiB;
constexpr size_t WS_WBT = 32 * MiB;
constexpr size_t WS_WOT = 38 * MiB;
constexpr size_t WS_WKVT = 42 * MiB;
constexpr size_t WS_PWT = 50 * MiB;
constexpr size_t WS_BIAS = 51 * MiB;
constexpr size_t WS_MEMN = 52 * MiB;
constexpr size_t WS_MKV = 56 * MiB;
constexpr size_t WS_H = 64 * MiB;
constexpr size_t WS_ARR = 128 * MiB;
constexpr size_t WS_POOLED = 416 * MiB;
constexpr size_t WS_IK = 448 * MiB;
constexpr size_t WS_IW = 452 * MiB;
constexpr size_t WS_BKT = 453 * MiB;
constexpr size_t WS_DIAG = 454 * MiB;
constexpr int A_POOLU = 0, A_AQ = 1, A_MQ = 2, A_IQ = 3, A_POOLZ = 4, A_AZ = 5, A_MZ = 6, A_AK = 7, A_AV = 8;
constexpr size_t WS_MERGED = WS_ARR + 7 * 32 * MiB;
constexpr size_t WS_BBUF = WS_ARR + 4 * 32 * MiB;

__device__ __forceinline__ int opaque_tid() { int t = threadIdx.x; asm volatile("" : "+v"(t)); return t; }
__device__ __forceinline__ float fast_rcp(float x) { return __builtin_amdgcn_rcpf(x); }
__device__ __forceinline__ float silu_fast(float z) { return z * fast_rcp(1.f + __expf(-z)); }
__device__ __forceinline__ float sigm_fast(float z) { return fast_rcp(1.f + __expf(-z)); }
__device__ __forceinline__ float silu_f(float z) { return z / (1.f + __expf(-z)); }
__device__ __forceinline__ float sigm_f(float z) { return 1.f / (1.f + __expf(-z)); }

__device__ __forceinline__ int w1_col(int n) {
    if (n < 3584) return n;
    if (n < 4096) return 3656 + (n - 3584);
    if (n < 4608) return 4168 + (n - 4096);
    if (n < 4672) return 3584 + (n - 4608);
    if (n < 4680) return 3648 + (n - 4672);
    return -1;
}
__device__ __forceinline__ void ph_convert_w(const float* __restrict__ src, int lds, int K, h16* __restrict__ dst, int ldd, int N, int mode, int coff, float* tile  ) {
    const int tix_ = opaque_tid();
    const int nbx = (N + 31) / 32, nby = (K + 31) / 32, tx = tix_ & 31, ty = tix_ >> 5;
    for (int vb = blockIdx.x; vb < nbx * nby; vb += gridDim.x) {
        const int n0 = (vb % nbx) * 32, k0 = (vb / nbx) * 32;
        for (int i = ty; i < 32; i += 16) {
            const int n = n0 + tx, k = k0 + i;
            int col = (mode == 1) ? w1_col(n) : coff + n;
            float v = 0.f;
            if (n < N && k < K && col >= 0) v = src[(size_t)k * lds + col];
            tile[i * 33 + tx] = v;
        }
        __syncthreads();
        for (int i = ty; i < 32; i += 16) {
            const int n = n0 + i, k = k0 + tx;
            if (n < N && k < K) dst[(size_t)n * ldd + k] = (h16)tile[tx * 33 + i];
        }
        __syncthreads();
    }
}
__device__ __forceinline__ void ph_convert_pw(const float* __restrict__ pw, h16* __restrict__ dst) {
    const int tix_ = opaque_tid();
    for (int idx = blockIdx.x * 512 + tix_; idx < 512 * 256; idx += gridDim.x * 512) {
        const int n = idx >> 8, kp = idx & 255, g = n >> 7, d = n & 127;
        float v = 0.f;
        if ((kp >> 7) == (g & 1)) v = pw[((size_t)g * 128 + (kp & 127)) * 128 + d];
        dst[idx] = (h16)v;
    }
}
__device__ __forceinline__ void ph_bias_tab(const float* __restrict__ rel_bias, float* __restrict__ tab, int* __restrict__ bkt) {
    const int tix_ = opaque_tid();
    for (int r = blockIdx.x * 512 + tix_; r < 8255; r += gridDim.x * 512) {
        const int rel = r - 8191;
        int ret = rel > 0 ? 16 : 0;
        const int n = rel < 0 ? -rel : rel;
        int bk;
        if (n < 8) bk = n;
        else {
            const float nf = (float)n;
            int large = 8 + (int)(logf(nf / 8.0f) / logf(128.0f) * 8.0f);
            bk = large < 15 ? large : 15;
        }
        ret += bk;
        bkt[r] = ret;
        for (int h = 0; h < 8; ++h) tab[h * BT_STRIDE + r] = rel_bias[ret * 8 + h];
    }
}

__device__ __forceinline__ float wave_sum(float v) {
#pragma unroll
    for (int o = 1; o < 64; o <<= 1) v += __shfl_xor(v, o);
    return v;
}
template <bool OUT_F32>
__device__ __forceinline__ void ph_rmsnorm(const float* x, const float* __restrict__ g, void* out, int rows) {
    const int tix_ = opaque_tid();
    const int lane = tix_ & 63;
    for (int row = blockIdx.x * 8 + (tix_ >> 6); row < rows; row += gridDim.x * 8) {
        const f32x4* xr = (const f32x4*)(x + (size_t)row * D) + lane;
        f32x4 v[4]; float s = 0.f;
#pragma unroll
        for (int j = 0; j < 4; ++j) { v[j] = xr[64 * j]; s += v[j].x * v[j].x + v[j].y * v[j].y + v[j].z * v[j].z + v[j].w * v[j].w; }
        const float r = rsqrtf(wave_sum(s) * (1.f / D) + EPS);
#pragma unroll
        for (int j = 0; j < 4; ++j) {
            const f32x4 gg = ((const f32x4*)g)[lane + 64 * j];
            f32x4 o = v[j] * r * gg;
            if (OUT_F32) ((f32x4*)((float*)out + (size_t)row * D))[lane + 64 * j] = o;
            else { h16x4 w = {(h16)o.x, (h16)o.y, (h16)o.z, (h16)o.w}; *(h16x4*)((h16*)out + (size_t)row * D + (lane + 64 * j) * 4) = w; }
        }
    }
}

namespace g8 {
#define G8_LAS __attribute__((address_space(3)))
constexpr int BM = 256, BK = 64, HALF = 128, HTB = HALF * BK * 2  , STAGE_BYTES = 8 * HTB;
__device__ __forceinline__ int lds_byte(int r, int c) { const int st = (r >> 4) * 2 + (c >> 5), rr = r & 15, cc = c & 31, ob = rr * 64 + cc * 2; return st * 1024 + (ob ^ (((ob >> 9) & 1) << 5)); }
__device__ __forceinline__ void stage_rc(int b, int& R, int& C) { const int st = b / 1024, sb = b % 1024, swz = sb ^ (((sb >> 9) & 1) << 5); R = (st >> 1) * 16 + swz / 64; C = (st & 1) * 32 + (swz % 64) / 2; }
__device__ __forceinline__ int perm32(int rho) { const int n = rho >> 4, i = rho & 15; return 8 * (i >> 2) + 4 * n + (i & 3); }

typedef G8_LAS unsigned char* G8_LAS_T;
struct Unit {
    const char* A;
    const char* B;
    int lda, ldb, nt;
    int pm, pn, op, aux;
};
template <class Sched, class Epi>
__device__ __forceinline__ void gemm_phase(G8_LAS unsigned char* lds, const Sched& S, const Epi& E) {
    const int tid = opaque_tid(), wid = __builtin_amdgcn_readfirstlane(tid >> 6), lane = tid & 63, wr = wid >> 2, wc = wid & 3, fr = lane & 15, fq = lane >> 4;
    unsigned sR[2], sRb[2], sC[2];
#pragma unroll
    for (int i = 0; i < 2; ++i) { int R, C; stage_rc(tid * 16 + i * 8192, R, C); sR[i] = 2u * R; sC[i] = 2u * C; sRb[i] = 2u * ((R & ~31) + perm32(R & 31)); }
    const size_t kstep = (size_t)(BK * 2);
    const unsigned ldsw = (unsigned)wid * 1024u;
    const int aoff = lds_byte(wr * 64 + fr, fq * 8), boff = lds_byte(wc * 32 + fr, fq * 8);
#define G8_SA(b, h) (((b) * 2 + (h)) * HTB)
#define G8_SB(b, h) ((4 + (b) * 2 + (h)) * HTB)
#define G8_STAGE_A(bufoff, gbase, ld) do { _Pragma("unroll") for (int _i = 0; _i < 2; ++_i) \
        __builtin_amdgcn_global_load_lds((const unsigned*)((const char*)(gbase) + (sR[_i] * (unsigned)(ld) + sC[_i])), (G8_LAS unsigned*)(lds + (bufoff) + ldsw + _i * 8192), 16, 0, 0); } while (0)
#define G8_STAGE_B(bufoff, gbase, ld) do { _Pragma("unroll") for (int _i = 0; _i < 2; ++_i) \
        __builtin_amdgcn_global_load_lds((const unsigned*)((const char*)(gbase) + (sRb[_i] * (unsigned)(ld) + sC[_i])), (G8_LAS unsigned*)(lds + (bufoff) + ldsw + _i * 8192), 16, 0, 0); } while (0)
#define G8_LDA(dst, b, h) do { _Pragma("unroll") for (int m = 0; m < 4; ++m) _Pragma("unroll") for (int k = 0; k < 2; ++k) dst[m][k] = *(const G8_LAS h16x8*)(lds + G8_SA(b, h) + aoff + m * 2048 + k * 1024); } while (0)
#define G8_LDB(dst, b, h) do { _Pragma("unroll") for (int n = 0; n < 2; ++n) _Pragma("unroll") for (int k = 0; k < 2; ++k) dst[n][k] = *(const G8_LAS h16x8*)(lds + G8_SB(b, h) + boff + n * 2048 + k * 1024); } while (0)
#define G8_MMA(ai, bj, At, Bt) do { __builtin_amdgcn_s_setprio(1); _Pragma("unroll") for (int m = 0; m < 4; ++m) _Pragma("unroll") for (int n = 0; n < 2; ++n) _Pragma("unroll") for (int k = 0; k < 2; ++k) \
        acc[ai][bj][m][n] = __builtin_amdgcn_mfma_f32_16x16x32_f16(Bt[n][k], At[m][k], acc[ai][bj][m][n], 0, 0, 0); __builtin_amdgcn_s_setprio(0); } while (0)
#define G8_WAIT_V(n) asm volatile("s_waitcnt vmcnt(" #n ")" ::: "memory")
#define G8_WAIT_L(n) asm volatile("s_waitcnt lgkmcnt(" #n ")" ::: "memory")
#define G8_BAR __builtin_amdgcn_s_barrier()
#define G8_SCHED __builtin_amdgcn_sched_barrier(0)
    Unit cur, nxt; int ui = 0;
    if (!S.next(0, cur)) return;
    f32x4 acc[2][2][4][2];
#pragma unroll
    for (int a = 0; a < 2; ++a)
#pragma unroll
        for (int b = 0; b < 2; ++b)
#pragma unroll
            for (int m = 0; m < 4; ++m)
#pragma unroll
                for (int n = 0; n < 2; ++n) acc[a][b][m][n] = (f32x4){0.f, 0.f, 0.f, 0.f};
    h16x8 At[4][2], B0[2][2], B1[2][2];
    const char* cA = cur.A; const char* cB = cur.B;
    int clda = cur.lda, cldb = cur.ldb;
    unsigned chA = (unsigned)HALF * clda * 2, chB = (unsigned)HALF * cldb * 2;
    G8_STAGE_B(G8_SB(0, 0), cB, cldb); G8_STAGE_B(G8_SB(0, 1), cB + chB, cldb); G8_STAGE_A(G8_SA(0, 0), cA, clda); G8_STAGE_A(G8_SA(0, 1), cA + chA, clda);
    if (wr == 1) G8_BAR;
    G8_WAIT_V(2); G8_BAR;
    G8_STAGE_B(G8_SB(1, 0), cB + kstep, cldb); G8_STAGE_A(G8_SA(1, 0), cA + kstep, clda); G8_STAGE_B(G8_SB(1, 1), cB + chB + kstep, cldb);
    G8_WAIT_V(6); G8_BAR;
    for (;;) {
        const bool has_next = S.next(ui + 1, nxt);
        const char* nA = cA; const char* nB = cB; unsigned nhA = chA, nhB = chB; int nlda = clda, nldb = cldb;
        if (has_next) { nA = nxt.A; nB = nxt.B; nlda = nxt.lda; nldb = nxt.ldb; nhA = (unsigned)HALF * nlda * 2; nhB = (unsigned)HALF * nldb * 2; }
        const int nt = cur.nt;
        for (int t = 0; t < nt; t += 2) {
            const bool last = (t == nt - 2);
            const char* a1 = cA + (size_t)(t + 1) * kstep;
            const char* a2 = last ? nA : cA + (size_t)(t + 2) * kstep; const char* b2 = last ? nB : cB + (size_t)(t + 2) * kstep;
            const char* a3 = a2 + kstep; const char* b3 = b2 + kstep;
            const unsigned h2A = last ? nhA : chA, h2B = last ? nhB : chB;
            const int l2A = last ? nlda : clda, l2B = last ? nldb : cldb;
            G8_LDB(B0, 0, 0); G8_LDB(B1, 0, 1); G8_SCHED; G8_LDA(At, 0, 0); G8_STAGE_A(G8_SA(1, 1), a1 + chA, clda);
            G8_WAIT_V(8); G8_WAIT_L(0); G8_BAR; G8_MMA(0, 0, At, B0); G8_MMA(0, 1, At, B1); G8_BAR; G8_SCHED;
            G8_LDA(At, 0, 1); G8_STAGE_B(G8_SB(0, 0), b2, l2B); G8_STAGE_B(G8_SB(0, 1), b2 + h2B, l2B); G8_STAGE_A(G8_SA(0, 0), a2, l2A);
            G8_WAIT_V(8); G8_WAIT_L(0); G8_BAR; G8_MMA(1, 0, At, B0); G8_MMA(1, 1, At, B1); G8_BAR; G8_SCHED;
            G8_LDB(B0, 1, 0); G8_LDB(B1, 1, 1); G8_SCHED; G8_LDA(At, 1, 0); G8_STAGE_A(G8_SA(0, 1), a2 + h2A, l2A);
            G8_WAIT_V(8); G8_WAIT_L(0); G8_BAR; G8_MMA(0, 0, At, B0); G8_MMA(0, 1, At, B1); G8_BAR; G8_SCHED;
            G8_LDA(At, 1, 1); G8_STAGE_B(G8_SB(1, 0), b3, l2B); G8_STAGE_B(G8_SB(1, 1), b3 + h2B, l2B); G8_STAGE_A(G8_SA(1, 0), a3, l2A);
            G8_WAIT_V(8); G8_WAIT_L(0); G8_BAR; G8_MMA(1, 0, At, B0); G8_MMA(1, 1, At, B1); G8_BAR; G8_SCHED;
        }
        if (wr == 0) G8_BAR;
        E(acc, cur, wr, wc, fr, fq);
        if (!has_next) break;
#pragma unroll
        for (int a = 0; a < 2; ++a)
#pragma unroll
            for (int b = 0; b < 2; ++b)
#pragma unroll
                for (int m = 0; m < 4; ++m)
#pragma unroll
                    for (int n = 0; n < 2; ++n) acc[a][b][m][n] = (f32x4){0.f, 0.f, 0.f, 0.f};
        cur = nxt; cA = nA; cB = nB; chA = nhA; chB = nhB; clda = nlda; cldb = nldb; ++ui;
        if (wr == 1) G8_BAR;
    }
    G8_WAIT_V(0);
    G8_BAR;
#undef G8_SA
#undef G8_SB
#undef G8_STAGE_A
#undef G8_STAGE_B
#undef G8_LDA
#undef G8_LDB
#undef G8_MMA
#undef G8_WAIT_V
#undef G8_WAIT_L
#undef G8_BAR
#undef G8_SCHED
}
}
__device__ __forceinline__ void ph_pooled(const h16* __restrict__ u, h16* __restrict__ pooled) {
    const int tix_ = opaque_tid();
    for (size_t idx = (size_t)blockIdx.x * 512 + tix_; idx < (size_t)T * 512; idx += (size_t)gridDim.x * 512) {
        const int c = (int)(idx & 511); const int t = (int)(idx >> 9); const int pos = t & (S - 1);
        const int w = 2 << (c >> 7);
        const int cnt = pos + 1 < w ? pos + 1 : w;
        float s = 0.f;
        for (int i = 0; i < cnt; ++i) s += (float)u[(size_t)(t - i) * 512 + c];
        pooled[idx] = (h16)(s / (float)cnt - (float)u[idx]);
    }
}

__device__ __forceinline__ float block_max(float v, float* red) {
#pragma unroll
    for (int o = 1; o < 64; o <<= 1) v = fmaxf(v, __shfl_xor(v, o));
    __syncthreads();
    if ((threadIdx.x & 63) == 0) red[threadIdx.x >> 6] = v;
    __syncthreads();
    return fmaxf(fmaxf(fmaxf(red[0], red[1]), fmaxf(red[2], red[3])), fmaxf(fmaxf(red[4], red[5]), fmaxf(red[6], red[7])));
}
__device__ __forceinline__ float block_sum(float v, float* red) {
    v = wave_sum(v);
    __syncthreads();
    if ((threadIdx.x & 63) == 0) red[threadIdx.x >> 6] = v;
    __syncthreads();
    return ((red[0] + red[1]) + (red[2] + red[3])) + ((red[4] + red[5]) + (red[6] + red[7]));
}
__device__ __forceinline__ int block_sum_i(int v, int* red) {
#pragma unroll
    for (int o = 1; o < 64; o <<= 1) v += __shfl_xor(v, o);
    __syncthreads();
    if ((threadIdx.x & 63) == 0) red[threadIdx.x >> 6] = v;
    __syncthreads();
    return ((red[0] + red[1]) + (red[2] + red[3])) + ((red[4] + red[5]) + (red[6] + red[7]));
}
__device__ __forceinline__ int block_exscan(int v, int* red, int* tot) {
    const int lane = threadIdx.x & 63, w = threadIdx.x >> 6;
    int inc = v;
#pragma unroll
    for (int o = 1; o < 64; o <<= 1) { int t = __shfl_up(inc, o); if (lane >= o) inc += t; }
    __syncthreads();
    if (lane == 63) red[w] = inc;
    __syncthreads();
    int base = 0, all = 0;
#pragma unroll
    for (int i = 0; i < 8; ++i) { const int r = red[i]; if (i < w) base += r; all += r; }
    *tot = all;
    return base + inc - v;
}

__device__ __forceinline__ void ph_memattn(const h16* mq, const h16* __restrict__ mkv, const h16* __restrict__ mz, h16* ymem, float* sm) {
    const int tix_ = opaque_tid();
    float* sq = sm; float* sp = sm + 512; float* red = sm + 1024;
    const int tid = tix_, hh = tid >> 8, j = tid & 255;
    for (int t = blockIdx.x; t < T; t += gridDim.x) {
        const int b = t / S;
        __syncthreads();
        sq[tid] = (float)mq[(size_t)t * 512 + tid];
        __syncthreads();
        for (int hp = 0; hp < 2; ++hp) {
            const int h = hp * 2 + hh;
            const h16* kr = mkv + (size_t)(b * 256 + j) * 1024 + h * 128;
            float s = 0.f;
            for (int d = 0; d < 128; ++d) s += sq[h * 128 + d] * (float)kr[d];
            s *= MEM_SCALE;
            float mx = s;
#pragma unroll
            for (int o = 1; o < 64; o <<= 1) mx = fmaxf(mx, __shfl_xor(mx, o));
            __syncthreads();
            if ((tid & 63) == 0) red[tid >> 6] = mx;
            __syncthreads();
            mx = fmaxf(fmaxf(red[hh * 4], red[hh * 4 + 1]), fmaxf(red[hh * 4 + 2], red[hh * 4 + 3]));
            const float p = __expf(s - mx);
            float sum = wave_sum(p);
            __syncthreads();
            if ((tid & 63) == 0) red[tid >> 6] = sum;
            sp[hh * 256 + j] = p;
            __syncthreads();
            sum = (red[hh * 4] + red[hh * 4 + 1]) + (red[hh * 4 + 2] + red[hh * 4 + 3]);
            if (j < 128) {
                float o = 0.f;
                for (int jj = 0; jj < 256; ++jj) o += sp[hh * 256 + jj] * (float)mkv[(size_t)(b * 256 + jj) * 1024 + 512 + h * 128 + j];
                o /= sum;
                const float z = (float)mz[(size_t)t * 512 + h * 128 + j];
                ymem[(size_t)t * 512 + h * 128 + j] = (h16)(o * silu_f(z));
            }
            __syncthreads();
        }
    }
}

__device__ __forceinline__ unsigned okey(float f) { const unsigned u = __float_as_uint(f); return (u & 0x80000000u) ? ~u : (u | 0x80000000u); }
__device__ __forceinline__ void ph_dsa(const h16* aq, const h16* __restrict__ ak, const h16* __restrict__ av, const h16* __restrict__ az, const h16* __restrict__ iq,
                                       const h16* __restrict__ ik, const float* __restrict__ iw, const float* __restrict__ btab, h16* yattn, unsigned* sm) {
    const int tix_ = opaque_tid();
    unsigned* sc = sm;
    float* siq = (float*)(sm + 8192);
    float* sqa = siq + 512;
    float* sw = sqa + 512;
    float* spsum = sw + 8;
    float* red = spsum + 8;
    int* redi = (int*)(red + 8);
    int* sel = redi + 8;
    float* lg = (float*)(sel + 256);
    const int tid = tix_;
    for (int t = blockIdx.x; t < T; t += gridDim.x) {
        const int b = t / S, pos = t % S, L = (pos / 64 + 1) * 64;
        __syncthreads();
        siq[tid] = (float)iq[(size_t)t * 512 + tid];
        sqa[tid] = (float)aq[(size_t)t * 512 + tid];
        if (tid < 8) sw[tid] = iw[(size_t)t * 8 + tid];
        __syncthreads();
        int nsel;
        if (L <= 256) {
            if (tid < L) sel[tid] = tid;
            nsel = L;
            __syncthreads();
        } else {
            const int chunk = (L + 511) / 512;
            const int s0 = min(L, tid * chunk), s1 = min(L, s0 + chunk);
            for (int s = s0; s < s1; ++s) {
                const h16* kr = ik + (size_t)(b * S + s) * 64;
                float I = 0.f;
                for (int h = 0; h < 8; ++h) {
                    float d = 0.f;
#pragma unroll 8
                    for (int e = 0; e < 64; ++e) d += siq[h * 64 + e] * (float)kr[e];
                    I += sw[h] * fmaxf(d, 0.f);
                }
                sc[s] = okey(I);
            }
            __syncthreads();
            unsigned prefix = 0u;
            for (int bit = 31; bit >= 0; --bit) {
                const unsigned cand = prefix | (1u << bit);
                int c = 0;
                for (int s = s0; s < s1; ++s) c += (sc[s] >= cand) ? 1 : 0;
                c = block_sum_i(c, redi);
                if (c >= 256) prefix = cand;
            }
            int cg_ = 0, ce = 0;
            for (int s = s0; s < s1; ++s) { cg_ += (sc[s] > prefix) ? 1 : 0; ce += (sc[s] == prefix) ? 1 : 0; }
            const int cgt = block_sum_i(cg_, redi);
            const int r = 256 - cgt;
            int tot;
            const int tie_before = block_exscan(ce, redi, &tot);
            int myc = 0; int tb = tie_before;
            for (int s = s0; s < s1; ++s) { const unsigned k = sc[s]; if (k > prefix) ++myc; else if (k == prefix) { if (tb < r) ++myc; ++tb; } }
            int tot2;
            int p = block_exscan(myc, redi, &tot2);
            tb = tie_before;
            for (int s = s0; s < s1; ++s) { const unsigned k = sc[s]; bool take = false; if (k > prefix) take = true; else if (k == prefix) { take = tb < r; ++tb; } if (take) sel[p++] = s; }
            nsel = tot2;
            __syncthreads();
        }
        if (tid < nsel) {
            const int s = sel[tid];
            const h16* kr = ak + (size_t)(b * S + s) * 512;
            for (int h = 0; h < 8; ++h) {
                float d = 0.f;
#pragma unroll 8
                for (int e = 0; e < 64; ++e) d += sqa[h * 64 + e] * (float)kr[h * 64 + e];
                lg[h * 256 + tid] = d * ATTN_SCALE + btab[h * BT_STRIDE + (s - pos + 8191)];
            }
        }
        __syncthreads();
        for (int h = 0; h < 8; ++h) {
            const float v = tid < nsel ? lg[h * 256 + tid] : -INFINITY;
            const float mx = block_max(v, red);
            const float p = tid < nsel ? __expf(v - mx) : 0.f;
            const float ps = block_sum(p, red);
            if (tid == 0) spsum[h] = ps;
            if (tid < nsel) lg[h * 256 + tid] = p;
        }
        __syncthreads();
        {
            const int o = tid, h = o >> 6;
            float acc = 0.f;
            for (int j = 0; j < nsel; ++j) acc += lg[h * 256 + j] * (float)av[(size_t)(b * S + sel[j]) * 512 + o];
            acc /= spsum[h];
            const float z = (float)az[(size_t)t * 512 + o];
            yattn[(size_t)t * 512 + o] = (h16)(acc * silu_f(z));
        }
    }
}


namespace pe {
typedef __attribute__((address_space(3))) unsigned lu32;
typedef __attribute__((address_space(3))) float lf32;
typedef __attribute__((address_space(3))) unsigned char lu8;
typedef unsigned u32x4 __attribute__((ext_vector_type(4)));
typedef float f32x16 __attribute__((ext_vector_type(16)));
constexpr int CAP = 512, TRIG = 448, TOPK = 256;
constexpr int L_LIST = 0;
constexpr int L_MASK = 0, MASK_STRIDE = 257;
constexpr int L_CNT = CAP * 64 * 4;
constexpr int L_TAU = L_CNT + 256;
constexpr int L_HIST = L_TAU + 256;
constexpr int L_FLAG = L_HIST + 8 * 1024;
constexpr int L_END = L_FLAG + 64;
static_assert(MASK_STRIDE * 64 * 4 <= L_CNT, "mask fits under the control words");

__device__ __forceinline__ unsigned okey(float f) { const unsigned u = __float_as_uint(f); return (u & 0x80000000u) ? ~u : (u | 0x80000000u); }
__device__ __forceinline__ float unokey(unsigned k) { return __uint_as_float((k & 0x80000000u) ? (k & 0x7fffffffu) : ~k); }
#define PE_LWAIT() asm volatile("s_waitcnt lgkmcnt(0)" ::: "memory")

__device__ __forceinline__ void score_tile(const h16x8 (&ak)[2][2], const h16x8 (&bq)[8][2], const float (&w)[8], f32x4& I0, f32x4& I1) {
    I0 = (f32x4){0.f, 0.f, 0.f, 0.f}; I1 = I0;
#pragma unroll
    for (int h = 0; h < 8; ++h) {
        f32x4 a0 = (f32x4){0.f, 0.f, 0.f, 0.f}, a1 = a0;
        a0 = __builtin_amdgcn_mfma_f32_16x16x32_f16(ak[0][0], bq[h][0], a0, 0, 0, 0);
        a1 = __builtin_amdgcn_mfma_f32_16x16x32_f16(ak[1][0], bq[h][0], a1, 0, 0, 0);
        a0 = __builtin_amdgcn_mfma_f32_16x16x32_f16(ak[0][1], bq[h][1], a0, 0, 0, 0);
        a1 = __builtin_amdgcn_mfma_f32_16x16x32_f16(ak[1][1], bq[h][1], a1, 0, 0, 0);
#pragma unroll
        for (int r = 0; r < 4; ++r) { I0[r] = fmaf(w[h], fmaxf(a0[r], 0.f), I0[r]); I1[r] = fmaf(w[h], fmaxf(a1[r], 0.f), I1[r]); }
    }
}
__device__ __forceinline__ void load_ik(h16x8 (&ak)[2][2], const h16* IK, size_t key0, int q, int q4) {
#pragma unroll
    for (int kb = 0; kb < 2; ++kb)
#pragma unroll
        for (int ks = 0; ks < 2; ++ks) ak[kb][ks] = *(const h16x8*)(IK + (key0 + 16 * kb + q) * 64 + ks * 32 + q4 * 8);
}
__device__ __forceinline__ void compact(lu32* list, lu32* cntp, lf32* taup, lu32* hist, int lane) {
    const int N = __builtin_amdgcn_readfirstlane((int)*cntp);
    unsigned key[8];
#pragma unroll
    for (int i = 0; i < 8; ++i) { const int idx = lane + 64 * i; key[i] = idx < N ? list[idx] : 0u; }
    unsigned prefix = 0u, mask = 0u; int need = TOPK;
#pragma unroll 1
    for (int pass = 0; pass < 4; ++pass) {
        const int shift = 24 - 8 * pass;
        *(__attribute__((address_space(3))) u32x4*)(hist + 4 * lane) = (u32x4){0u, 0u, 0u, 0u};
        PE_LWAIT();
#pragma unroll
        for (int i = 0; i < 8; ++i) if ((key[i] & mask) == prefix) __hip_atomic_fetch_add(hist + ((key[i] >> shift) & 255u), 1u, __ATOMIC_RELAXED, __HIP_MEMORY_SCOPE_WORKGROUP);
        PE_LWAIT();
        const u32x4 b4 = *(const __attribute__((address_space(3))) u32x4*)(hist + 4 * (63 - lane));
        const int s = (int)(b4[0] + b4[1] + b4[2] + b4[3]);
        int incl = s;
#pragma unroll
        for (int o = 1; o < 64; o <<= 1) { const int t = __shfl_up(incl, o); if (lane >= o) incl += t; }
        const unsigned long long bal = __ballot(incl >= need);
        const int Ls = __builtin_amdgcn_readfirstlane((int)__builtin_ctzll(bal));
        int e = incl - s, d = 255 - 4 * lane, dstar = 0, rank = 0; bool found = false;
#pragma unroll
        for (int j = 3; j >= 0; --j) { const int bb = (int)b4[j]; if (!found) { if (e + bb >= need) { found = true; dstar = d; rank = need - e; } else { e += bb; --d; } } }
        dstar = __builtin_amdgcn_readlane(dstar, Ls); rank = __builtin_amdgcn_readlane(rank, Ls);
        prefix |= (unsigned)dstar << shift; mask |= 255u << shift; need = rank;
        PE_LWAIT();
    }
    int pos = 0;
#pragma unroll
    for (int i = 0; i < 8; ++i) {
        const bool f = key[i] > prefix;
        const unsigned long long bal = __ballot(f);
        const int off = __builtin_popcountll(bal & ((1ull << lane) - 1ull));
        if (f) list[pos + off] = key[i];
        pos += __builtin_popcountll(bal);
    }
    for (int k = lane; k < need; k += 64) list[pos + k] = prefix;
    if (lane == 0) { *cntp = (unsigned)TOPK; *taup = unokey(prefix); }
    PE_LWAIT();
}

struct Tens { const h16 *IQ, *IK, *AQ, *AZ, *KF, *VF; const float *IW, *BTAB; const int* BKT; h16* Y; float* TAU; };

__device__ __forceinline__ void unit(const Tens& X, int b, int c, lu8* lds, int tid_) {
    int tid = tid_; asm volatile("" : "+v"(tid));
    int lane = tid & 63; const int w = __builtin_amdgcn_readfirstlane(tid >> 6);
    lu32* LIST = (lu32*)(lds + L_LIST); lu32* CNT = (lu32*)(lds + L_CNT); lf32* TAU = (lf32*)(lds + L_TAU);
    lu32* HIST = (lu32*)(lds + L_HIST) + 256 * w; lu32* FLAG = (lu32*)(lds + L_FLAG); lu32* MASK = (lu32*)(lds + L_MASK);
    const size_t tok0 = (size_t)b * S + 64 * c;
    const size_t kbase = (size_t)b * S;
    const int ntile = c + 1;
    {
        const int qg = w & 3, kh = w >> 2, q = lane & 15, q4 = lane >> 4, ql = 16 * qg + q;
        const size_t tq = tok0 + ql;
        h16x8 bq[8][2]; float wv[8];
#pragma unroll
        for (int h = 0; h < 8; ++h)
#pragma unroll
            for (int ks = 0; ks < 2; ++ks) bq[h][ks] = *(const h16x8*)(X.IQ + tq * 512 + h * 64 + ks * 32 + q4 * 8);
        { const f32x4 w0 = *(const f32x4*)(X.IW + tq * 8), w1 = *(const f32x4*)(X.IW + tq * 8 + 4);
#pragma unroll
          for (int e = 0; e < 4; ++e) { wv[e] = w0[e]; wv[4 + e] = w1[e]; } }
        if (tid < 64) { CNT[tid] = 0u; TAU[tid] = -INFINITY; }
        if (tid < 4) FLAG[tid] = 0u;
        __syncthreads();
        if (c >= 4) {
            h16x8 akc[2][2], akn[2][2];
            load_ik(akc, X.IK, kbase + 32 * kh, q, q4);
#pragma unroll 1
            for (int j = 0; j < ntile; ++j) {
                if (j + 1 < ntile) load_ik(akn, X.IK, kbase + 64 * (j + 1) + 32 * kh, q, q4);
                f32x4 I0, I1; score_tile(akc, bq, wv, I0, I1);
                const float tau = TAU[ql];
                unsigned f = 0u;
#pragma unroll
                for (int r = 0; r < 4; ++r) { f |= (I0[r] > tau ? 1u : 0u) << r; f |= (I1[r] > tau ? 1u : 0u) << (4 + r); }
                const int nc = __builtin_popcount(f);
                const int slot = j % 3;
                if (nc) {
                    unsigned base = __hip_atomic_fetch_add(CNT + ql, (unsigned)nc, __ATOMIC_RELAXED, __HIP_MEMORY_SCOPE_WORKGROUP);
                    lu32* lp = LIST + ql * CAP;
#pragma unroll
                    for (int r = 0; r < 4; ++r) if (f & (1u << r)) lp[base++] = okey(I0[r]);
#pragma unroll
                    for (int r = 0; r < 4; ++r) if (f & (16u << r)) lp[base++] = okey(I1[r]);
                    if (base > (unsigned)TRIG) FLAG[slot] = 1u;
                }
                __syncthreads();
                const unsigned fl = FLAG[slot];
                if (tid == 0) FLAG[(j + 2) % 3] = 0u;
                if (fl) {
#pragma unroll 1
                    for (int i = 0; i < 8; ++i) { const int qq = 8 * w + i; if ((int)CNT[qq] > TRIG) compact(LIST + qq * CAP, CNT + qq, TAU + qq, HIST, lane); }
                    __syncthreads();
                }
#pragma unroll
                for (int kb = 0; kb < 2; ++kb)
#pragma unroll
                    for (int ks = 0; ks < 2; ++ks) akc[kb][ks] = akn[kb][ks];
            }
#pragma unroll 1
            for (int i = 0; i < 8; ++i) { const int qq = 8 * w + i; if ((int)CNT[qq] > TOPK) compact(LIST + qq * CAP, CNT + qq, TAU + qq, HIST, lane); }
            __syncthreads();
        }
        if (X.TAU && tid < 64) X.TAU[tok0 + tid] = TAU[tid];
        for (int i = tid; i < 64 * MASK_STRIDE; i += 512) MASK[i] = 0u;
        __syncthreads();
        {
            const float tau = TAU[ql];
            h16x8 akc[2][2], akn[2][2];
            load_ik(akc, X.IK, kbase + 32 * kh, q, q4);
#pragma unroll 1
            for (int j = 0; j < ntile; ++j) {
                if (j + 1 < ntile) load_ik(akn, X.IK, kbase + 64 * (j + 1) + 32 * kh, q, q4);
                f32x4 I0, I1; score_tile(akc, bq, wv, I0, I1);
                unsigned n0 = 0u, n1 = 0u;
#pragma unroll
                for (int r = 0; r < 4; ++r) { n0 |= (I0[r] >= tau ? 1u : 0u) << r; n1 |= (I1[r] >= tau ? 1u : 0u) << r; }
                const unsigned bits = (n0 << (4 * q4)) | (n1 << (16 + 4 * q4));
                __hip_atomic_fetch_or(MASK + ql * MASK_STRIDE + 2 * j + kh, bits, __ATOMIC_RELAXED, __HIP_MEMORY_SCOPE_WORKGROUP);
#pragma unroll
                for (int kb = 0; kb < 2; ++kb)
#pragma unroll
                    for (int ks = 0; ks < 2; ++ks) akc[kb][ks] = akn[kb][ks];
            }
        }
        __syncthreads();
    }
    {
        asm volatile("" : "+v"(lane));
        const int h = w, r32 = lane & 31, hh = lane >> 5;
        h16x8 bqf[2][4];
#pragma unroll
        for (int qb = 0; qb < 2; ++qb)
#pragma unroll
            for (int ks = 0; ks < 4; ++ks) bqf[qb][ks] = *(const h16x8*)(X.AQ + (tok0 + 32 * qb + r32) * 512 + h * 64 + 16 * ks + 8 * hh);
        f32x16 O[2][2]; float mrun[2], lrun[2];
#pragma unroll
        for (int qb = 0; qb < 2; ++qb) { mrun[qb] = -INFINITY; lrun[qb] = 0.f;
#pragma unroll
            for (int db = 0; db < 2; ++db)
#pragma unroll
                for (int e = 0; e < 16; ++e) O[qb][db][e] = 0.f; }
        const h16* kfp = X.KF + ((size_t)(b * 8 + h) * 256) * 2048 + (size_t)lane * 8;
        const h16* vfp = X.VF + ((size_t)(b * 8 + h) * 256) * 2048 + (size_t)lane * 8;
        const int nstep = 2 * ntile;
        const int qpos0 = 64 * c;
        h16x8 kf[4], vf[4], kfn[4], vfn[4];
#pragma unroll
        for (int i = 0; i < 4; ++i) { kf[i] = *(const h16x8*)(kfp + i * 512); vf[i] = *(const h16x8*)(vfp + i * 512); }
#pragma unroll 1
        for (int st = 0; st < nstep; ++st) {
            if (st + 1 < nstep) {
#pragma unroll
                for (int i = 0; i < 4; ++i) { kfn[i] = *(const h16x8*)(kfp + (size_t)(st + 1) * 2048 + i * 512); vfn[i] = *(const h16x8*)(vfp + (size_t)(st + 1) * 2048 + i * 512); }
            }
            const int k0 = 32 * st;
            const int relmin = k0 - (qpos0 + 63), relmax = k0 + 31 - qpos0;
            const bool ubias = (relmax <= 0) && (X.BKT[relmin + 8191] == X.BKT[relmax + 8191]);
            const float bu = X.BTAB[h * BT_STRIDE + relmin + 8191];
#pragma unroll
            for (int qb = 0; qb < 2; ++qb) {
                f32x16 Sx;
#pragma unroll
                for (int e = 0; e < 16; ++e) Sx[e] = 0.f;
#pragma unroll
                for (int ks = 0; ks < 4; ++ks) Sx = __builtin_amdgcn_mfma_f32_32x32x16_f16(kf[ks], bqf[qb][ks], Sx, 0, 0, 0);
                const unsigned word = MASK[(32 * qb + r32) * MASK_STRIDE + st] >> (4 * hh);
                float x[16];
                if (ubias) {
#pragma unroll
                    for (int e = 0; e < 16; ++e) x[e] = fmaf(Sx[e], ATTN_SCALE, bu);
                } else {
                    const float* bt = X.BTAB + h * BT_STRIDE + (k0 + 4 * hh - (qpos0 + 32 * qb + r32) + 8191);
#pragma unroll
                    for (int e = 0; e < 16; ++e) x[e] = fmaf(Sx[e], ATTN_SCALE, bt[(e & 3) + 8 * (e >> 2)]);
                }
                float mx = -INFINITY;
#pragma unroll
                for (int e = 0; e < 16; ++e) { const bool sel = (word >> ((e & 3) + 8 * (e >> 2))) & 1u; x[e] = sel ? x[e] : -INFINITY; mx = fmaxf(mx, x[e]); }
                mx = fmaxf(mx, __shfl_xor(mx, 32));
                const float mnew = fmaxf(mrun[qb], mx);
                const float msafe = (mnew == -INFINITY) ? 0.f : mnew;
                const float alpha = __expf(mrun[qb] - msafe);
                float rs = 0.f;
#pragma unroll
                for (int e = 0; e < 16; ++e) { x[e] = __expf(x[e] - msafe); rs += x[e]; }
                lrun[qb] = lrun[qb] * alpha + rs; mrun[qb] = mnew;
#pragma unroll
                for (int db = 0; db < 2; ++db)
#pragma unroll
                    for (int e = 0; e < 16; ++e) O[qb][db][e] *= alpha;
                h16x8 pf[2];
#pragma unroll
                for (int s2 = 0; s2 < 2; ++s2)
#pragma unroll
                    for (int e = 0; e < 8; ++e) pf[s2][e] = (h16)x[8 * s2 + e];
#pragma unroll
                for (int s2 = 0; s2 < 2; ++s2)
#pragma unroll
                    for (int db = 0; db < 2; ++db) O[qb][db] = __builtin_amdgcn_mfma_f32_32x32x16_f16(vf[s2 * 2 + db], pf[s2], O[qb][db], 0, 0, 0);
            }
#pragma unroll
            for (int i = 0; i < 4; ++i) { kf[i] = kfn[i]; vf[i] = vfn[i]; }
        }
#pragma unroll
        for (int qb = 0; qb < 2; ++qb) {
            const float lt = lrun[qb] + __shfl_xor(lrun[qb], 32);
            const float inv = 1.f / lt;
            const size_t trow = (tok0 + 32 * qb + r32) * 512 + h * 64;
#pragma unroll
            for (int db = 0; db < 2; ++db)
#pragma unroll
                for (int g = 0; g < 4; ++g) {
                    const int d = 32 * db + 8 * g + 4 * hh;
                    const h16x4 z = *(const h16x4*)(X.AZ + trow + d);
                    h16x4 o;
#pragma unroll
                    for (int e = 0; e < 4; ++e) o[e] = (h16)(O[qb][db][4 * g + e] * inv * silu_fast((float)z[e]));
                    *(h16x4*)(X.Y + trow + d) = o;
                }
        }
    }
    __syncthreads();
}

__device__ __forceinline__ void phase(const Tens& X, lu8* lds, int G, int vc) {
    const int tid = opaque_tid();
    const int nun = (G == 256) ? 2 : (512 - vc + G - 1) / G;
#pragma unroll 1
    for (int it = 0; it < nun; ++it) {
        int b, c;
        if (G == 256) { b = vc >> 6; c = it ? (vc & 63) : 127 - (vc & 63); } else { const int u = vc + it * G; b = u >> 7; c = u & 127; }
        unit(X, b, c, lds, tid);
    }
}
}

namespace ma {
typedef __attribute__((address_space(3))) unsigned char lu8;
typedef __attribute__((address_space(3))) h16x8 lh16x8;
typedef __attribute__((address_space(3))) h16 lh16;
typedef float f32x16 __attribute__((ext_vector_type(16)));
constexpr int L_K = 0, L_V = 65536;
__device__ __forceinline__ void phase(const h16* MQ, const h16* __restrict__ MKVl, const h16* __restrict__ MZ, h16* Y, lu8* lds, int G, int vc) {
    const int tid = opaque_tid(), lane = tid & 63, w = __builtin_amdgcn_readfirstlane(tid >> 6), r32 = lane & 31, hh = lane >> 5;
#pragma unroll 1
    for (int task = vc; task < 256; task += G) {
        const int pair = task >> 4, sub = task & 15, b = pair >> 2, h = pair & 3;
        __syncthreads();
        for (int i = tid; i < 4096; i += 512) {
            const int key = i >> 4, d8 = i & 15;
            const h16x8 kv = *(const h16x8*)(MKVl + (size_t)(b * 256 + key) * 1024 + h * 128 + d8 * 8);
            *(lh16x8*)(lds + L_K + ((((key >> 5) * 8 + (d8 >> 1)) * 64) + (key & 31) + 32 * (d8 & 1)) * 16) = kv;
            const h16x8 vv = *(const h16x8*)(MKVl + (size_t)(b * 256 + key) * 1024 + 512 + h * 128 + d8 * 8);
            const int kk = key & 31, s2 = kk >> 4, k16 = kk & 15, vh = (k16 >> 2) & 1, jj = ((k16 >> 3) << 2) | (k16 & 3);
            const int db = d8 >> 2, rr = (d8 & 3) * 8;
            lh16* vp = (lh16*)(lds + L_V) + (((((key >> 5) * 2 + s2) * 4 + db) * 64) + rr + 32 * vh) * 8 + jj;
#pragma unroll
            for (int e = 0; e < 8; ++e) vp[e * 8] = vv[e];
        }
        __syncthreads();
#pragma unroll 1
        for (int round = 0; round < 2; ++round) {
            const int qblk = sub * 16 + round * 8 + w;
            const size_t tok0 = (size_t)b * S + (size_t)qblk * 32;
            const size_t trow = (tok0 + r32) * 512 + h * 128;
            h16x8 qf[8];
#pragma unroll
            for (int ks = 0; ks < 8; ++ks) qf[ks] = *(const h16x8*)(MQ + trow + 16 * ks + 8 * hh);
            f32x16 O[4]; float mrun = -INFINITY, lrun = 0.f;
#pragma unroll
            for (int db = 0; db < 4; ++db)
#pragma unroll
                for (int e = 0; e < 16; ++e) O[db][e] = 0.f;
#pragma unroll 1
            for (int kb = 0; kb < 8; ++kb) {
                f32x16 Sx;
#pragma unroll
                for (int e = 0; e < 16; ++e) Sx[e] = 0.f;
#pragma unroll
                for (int ks = 0; ks < 8; ++ks) Sx = __builtin_amdgcn_mfma_f32_32x32x16_f16(*(const lh16x8*)(lds + L_K + ((kb * 8 + ks) * 64 + lane) * 16), qf[ks], Sx, 0, 0, 0);
                float x[16]; float mx = -INFINITY;
#pragma unroll
                for (int e = 0; e < 16; ++e) { x[e] = Sx[e] * MEM_SCALE; mx = fmaxf(mx, x[e]); }
                mx = fmaxf(mx, __shfl_xor(mx, 32));
                const float mnew = fmaxf(mrun, mx);
                const float alpha = __expf(mrun - mnew);
                float rs = 0.f;
#pragma unroll
                for (int e = 0; e < 16; ++e) { x[e] = __expf(x[e] - mnew); rs += x[e]; }
                lrun = lrun * alpha + rs; mrun = mnew;
#pragma unroll
                for (int db = 0; db < 4; ++db)
#pragma unroll
                    for (int e = 0; e < 16; ++e) O[db][e] *= alpha;
                h16x8 pf[2];
#pragma unroll
                for (int s2 = 0; s2 < 2; ++s2)
#pragma unroll
                    for (int e = 0; e < 8; ++e) pf[s2][e] = (h16)x[8 * s2 + e];
#pragma unroll
                for (int s2 = 0; s2 < 2; ++s2)
#pragma unroll
                    for (int db = 0; db < 4; ++db)
                        O[db] = __builtin_amdgcn_mfma_f32_32x32x16_f16(*(const lh16x8*)(lds + L_V + (((kb * 2 + s2) * 4 + db) * 64 + lane) * 16), pf[s2], O[db], 0, 0, 0);
            }
            const float lt = lrun + __shfl_xor(lrun, 32);
            const float inv = 1.f / lt;
#pragma unroll
            for (int db = 0; db < 4; ++db)
#pragma unroll
                for (int g = 0; g < 4; ++g) {
                    const int d = 32 * db + 8 * g + 4 * hh;
                    const h16x4 z = *(const h16x4*)(MZ + trow + d);
                    h16x4 o;
#pragma unroll
                    for (int e = 0; e < 4; ++e) o[e] = (h16)(O[db][4 * g + e] * inv * silu_fast((float)z[e]));
                    *(h16x4*)(Y + trow + d) = o;
                }
        }
    }
    __syncthreads();
}
}

enum { OP_STORE = 0, OP_IKIW = 1, OP_POOLMIX = 2, OP_GATE = 3, OP_BR0 = 4, OP_BR1 = 5, OP_BR2 = 6, OP_OUT = 7, OP_MKV = 8, OP_KF = 9, OP_VF = 10 };
enum { PH_GEMM1 = 0, PH_POOLMIX = 1, PH_MERGE = 2, PH_OUT = 3 };
constexpr int NXCD = 8, WGM = 8;
struct Bufs {
    char* ws; const float* pool_scale; const float* xin; float* xout; h16* kf; h16* vf;
#define BUF_ACC(name, off, type) __device__ __forceinline__ type* name() const { return (type*)(ws + (off)); }
    BUF_ACC(W1T, WS_W1T, h16) BUF_ACC(WGT, WS_WGT, h16) BUF_ACC(WBT, WS_WBT, h16) BUF_ACC(WOT, WS_WOT, h16) BUF_ACC(WKVT, WS_WKVT, h16) BUF_ACC(PWT, WS_PWT, h16)
    BUF_ACC(MEMN, WS_MEMN, h16) BUF_ACC(MKV, WS_MKV, h16) BUF_ACC(H, WS_H, h16) BUF_ACC(ARR, WS_ARR, h16) BUF_ACC(POOLED, WS_POOLED, h16) BUF_ACC(IK, WS_IK, h16)
    BUF_ACC(MERGED, WS_MERGED, h16) BUF_ACC(GS, WS_BBUF, h16) BUF_ACC(IW, WS_IW, float) BUF_ACC(BT, WS_BIAS, float)
#undef BUF_ACC
};
__device__ __forceinline__ void tile_order(int L, int nM, int nN, int& pm, int& pn) {
    const int nwg = nM * nN;
    int wgid = L; { const int q = nwg / NXCD, r = nwg % NXCD, xcd = wgid % NXCD, off = wgid / NXCD; wgid = (xcd < r ? xcd * (q + 1) : r * (q + 1) + (xcd - r) * q) + off; }
    const int nig = WGM * nN, gid = wgid / nig, fm = gid * WGM, gsz = (nM - fm) < WGM ? (nM - fm) : WGM;
    pm = fm + ((wgid % nig) % gsz); pn = (wgid % nig) / gsz;
}
struct Sched {
    int phase, layer, G, c, vc; Bufs b;
    __device__ __forceinline__ bool next(int i, g8::Unit& u) const {
        const size_t ASZ = (size_t)T * 512;
        if (phase == PH_GEMM1) {
            const int nmain = 128 * 19, L = i * G + c;
            if (L < nmain) {
                int pm, pn; tile_order(L, 128, 19, pm, pn);
                u.A = (const char*)(b.H() + (size_t)pm * 256 * D); u.lda = D;
                u.B = (const char*)(b.W1T() + (size_t)layer * N1 * D + (size_t)pn * 256 * D); u.ldb = D; u.nt = 16; u.pm = pm; u.pn = pn;
                if (pn < 18) {
                    const int a = pn >> 1;
                    const int slot = (a == 0) ? A_POOLU : (a == 1) ? A_POOLZ : (a == 2) ? A_AQ : (a == 3) ? A_AK : (a == 4) ? A_AV : (a == 5) ? A_AZ : (a == 6) ? A_IQ : (a == 7) ? A_MQ : A_MZ;
                    u.op = (a == 3) ? OP_KF : (a == 4) ? OP_VF : OP_STORE; u.aux = slot;
                } else { u.op = OP_IKIW; u.aux = 0; }
                return true;
            }
            if (layer == 0 && L < nmain + 32) {
                const int e = L - nmain, ly = e >> 4, pm = (e & 15) >> 2, pn = e & 3;
                u.A = (const char*)(b.MEMN() + (size_t)ly * 1024 * D + (size_t)pm * 256 * D); u.lda = D;
                u.B = (const char*)(b.WKVT() + (size_t)ly * 1024 * D + (size_t)pn * 256 * D); u.ldb = D; u.nt = 16; u.pm = pm; u.pn = pn;
                u.op = OP_MKV; u.aux = ly;
                return true;
            }
            return false;
        } else if (phase == PH_POOLMIX) {
            const int L = i * G + vc; if (L >= 256) return false;
            const int pm = L >> 1, pn = L & 1;
            u.A = (const char*)(b.POOLED() + (size_t)pm * 256 * 512 + pn * 256); u.lda = 512;
            u.B = (const char*)(b.PWT() + (size_t)layer * 512 * 256 + (size_t)pn * 256 * 256); u.ldb = 256; u.nt = 4; u.pm = pm; u.pn = pn;
            u.op = OP_POOLMIX; u.aux = 0;
            return true;
        } else if (phase == PH_MERGE) {
            const int j = i / 6, sub = i - 6 * j, ot = j * G + vc; if (ot >= 512) return false;
            const int pm = ot >> 2, pn = ot & 3, br = sub >> 1;
            u.pm = pm; u.pn = pn;
            if ((sub & 1) == 0) {
                u.A = (const char*)(b.H() + (size_t)pm * 256 * D); u.lda = D;
                u.B = (const char*)(b.WGT() + (size_t)layer * 3072 * D + (size_t)(br * 1024 + pn * 256) * D); u.ldb = D; u.nt = 16;
                u.op = OP_GATE; u.aux = 0;
            } else {
                const int slot = br == 0 ? A_POOLU : br == 1 ? A_AQ : A_MQ;
                u.A = (const char*)(b.ARR() + (size_t)slot * ASZ + (size_t)pm * 256 * 512); u.lda = 512;
                u.B = (const char*)(b.WBT() + ((size_t)layer * 3 + br) * 1024 * 512 + (size_t)pn * 256 * 512); u.ldb = 512; u.nt = 8;
                u.op = OP_BR0 + br; u.aux = 0;
            }
            return true;
        } else {
            const int ot = i * G + vc; if (ot >= 512) return false;
            const int pm = ot >> 2, pn = ot & 3;
            u.A = (const char*)(b.MERGED() + (size_t)pm * 256 * D); u.lda = D;
            u.B = (const char*)(b.WOT() + (size_t)layer * D * D + (size_t)pn * 256 * D); u.ldb = D; u.nt = 16; u.pm = pm; u.pn = pn;
            u.op = OP_OUT; u.aux = 0;
            return true;
        }
    }
};
__device__ __forceinline__ h16x8 cvt8(const f32x4& a, const f32x4& b) { h16x8 r = {(h16)a[0], (h16)a[1], (h16)a[2], (h16)a[3], (h16)b[0], (h16)b[1], (h16)b[2], (h16)b[3]}; return r; }
struct Epi {
    Bufs b;
#define EPI_LOOP(...) _Pragma("unroll") for (int ai = 0; ai < 2; ++ai) _Pragma("unroll") for (int m = 0; m < 4; ++m) { \
        const int rl = ai * 128 + wr * 64 + m * 16 + fr; const size_t rg = (size_t)u.pm * 256 + rl; (void)rg; \
        _Pragma("unroll") for (int bj = 0; bj < 2; ++bj) { const int cl = bj * 128 + wc * 32 + fq * 8; const int j = (ai * 4 + m) * 2 + bj; (void)j; \
            const f32x4 v0 = acc[ai][bj][m][0], v1 = acc[ai][bj][m][1]; __VA_ARGS__ } asm volatile("" ::: "memory"); }
    __device__ __forceinline__ void operator()(const f32x4 (&acc)[2][2][4][2], const g8::Unit& u, int wr_, int wc_, int fr_, int fq_) const {
        const int tid = opaque_tid();
        const int lane = tid & 63, wid = tid >> 6, wr = wid >> 2, wc = wid & 3, fr = lane & 15, fq = lane >> 4;
        const int op = u.op;
        if (op == OP_STORE) {
            h16* dst = b.ARR() + (size_t)u.aux * ((size_t)T * 512) + (u.pn & 1) * 256;
            EPI_LOOP({ *(h16x8*)(dst + rg * 512 + cl) = cvt8(v0, v1); })
        } else if (op == OP_KF) {
#if PROBE
            { h16* dst = b.ARR() + (size_t)u.aux * ((size_t)T * 512) + (u.pn & 1) * 256; EPI_LOOP({ *(h16x8*)(dst + rg * 512 + cl) = cvt8(v0, v1); }) }
#endif
            EPI_LOOP({
                const int bb = (int)(rg >> 13), sp = (int)(rg & 8191), cc = (u.pn & 1) * 256 + cl, hd = cc >> 6, d = cc & 63;
                const size_t off = ((((size_t)(bb * 8 + hd) * 256 + (sp >> 5)) * 4 + (d >> 4)) * 64 + ((sp & 31) + 32 * ((d >> 3) & 1))) * 8;
                *(h16x8*)(b.kf + off) = cvt8(v0, v1); })
        } else if (op == OP_VF) {
#if PROBE
            { h16* dst = b.ARR() + (size_t)u.aux * ((size_t)T * 512) + (u.pn & 1) * 256; EPI_LOOP({ *(h16x8*)(dst + rg * 512 + cl) = cvt8(v0, v1); }) }
#endif
            EPI_LOOP({
                const int bb = (int)(rg >> 13), sp = (int)(rg & 8191), cc = (u.pn & 1) * 256 + cl, hd = cc >> 6, d0 = cc & 63;
                const int kk = sp & 31, s2 = kk >> 4, k16 = kk & 15, hh = (k16 >> 2) & 1, jj = ((k16 >> 3) << 2) | (k16 & 3);
                h16* dst = b.vf + ((((((size_t)(bb * 8 + hd) * 256 + (sp >> 5)) * 2 + s2) * 2 + (d0 >> 5)) * 64 + ((d0 & 31) + 32 * hh)) * 8 + jj);
                const h16x8 hv = cvt8(v0, v1);
                _Pragma("unroll") for (int e = 0; e < 8; ++e) dst[e * 8] = hv[e]; })
        } else if (op == OP_MKV) {
            h16* dst = b.MKV() + (size_t)u.aux * 1024 * 1024 + u.pn * 256;
            EPI_LOOP({ *(h16x8*)(dst + rg * 1024 + cl) = cvt8(v0, v1); })
        } else if (op == OP_IKIW) {
            EPI_LOOP({ if (bj == 0) {
                if (wc < 2) *(h16x8*)(b.IK() + rg * 64 + cl) = cvt8(v0, v1);
                else if (wc == 2 && fq == 0) { *(f32x4*)(b.IW() + rg * 8) = v0 * IDX_W_SCALE; *(f32x4*)(b.IW() + rg * 8 + 4) = v1 * IDX_W_SCALE; } } })
        } else if (op == OP_POOLMIX) {
            EPI_LOOP({
                const int cg_ = u.pn * 256 + cl;
                const h16x8 z = *(const h16x8*)(b.ARR() + (size_t)A_POOLZ * ((size_t)T * 512) + rg * 512 + cg_);
                const f32x4 s0 = *(const f32x4*)(b.pool_scale + cg_), s1 = *(const f32x4*)(b.pool_scale + cg_ + 4);
                f32x4 y0, y1;
                _Pragma("unroll") for (int e = 0; e < 4; ++e) { y0[e] = v0[e] * s0[e] * silu_fast((float)z[e]); y1[e] = v1[e] * s1[e] * silu_fast((float)z[4 + e]); }
                *(h16x8*)(b.ARR() + (size_t)A_POOLU * ((size_t)T * 512) + rg * 512 + cg_) = cvt8(y0, y1); })
        } else if (op == OP_GATE) {
            EPI_LOOP({
                f32x4 g0, g1;
                _Pragma("unroll") for (int e = 0; e < 4; ++e) { g0[e] = sigm_fast(v0[e]); g1[e] = sigm_fast(v1[e]); }
                *(h16x8*)(b.GS() + ((size_t)blockIdx.x * 16 * 512 + (size_t)j * 512 + tid) * 8) = cvt8(g0, g1); })
        } else if (op == OP_OUT) {
            EPI_LOOP({
                const size_t o = rg * 1024 + u.pn * 256 + cl;
                const f32x4 x0 = *(const f32x4*)(b.xin + o), x1 = *(const f32x4*)(b.xin + o + 4);
                *(f32x4*)(b.xout + o) = x0 + v0; *(f32x4*)(b.xout + o + 4) = x1 + v1; })
        } else {
            const bool first = (op == OP_BR0);
            EPI_LOOP({
                const h16x8 g = *(const h16x8*)(b.GS() + ((size_t)blockIdx.x * 16 * 512 + (size_t)j * 512 + tid) * 8);
                f32x4 y0, y1;
                _Pragma("unroll") for (int e = 0; e < 4; ++e) { y0[e] = (float)g[e] * v0[e]; y1[e] = (float)g[4 + e] * v1[e]; }
                h16x8* mp = (h16x8*)(b.MERGED() + rg * 1024 + u.pn * 256 + cl);
                if (!first) { const h16x8 mo = *mp;
                    _Pragma("unroll") for (int e = 0; e < 4; ++e) { y0[e] += (float)mo[e]; y1[e] += (float)mo[4 + e]; } }
                *mp = cvt8(y0, y1); })
        }
    }
#undef EPI_LOOP
};
struct Params {
    const float *x, *mem, *norm_g, *w_in, *pool_w, *pool_scale, *mem_norm_g, *w_mem_kv, *w_branch, *w_out, *rel_bias, *final_g;
    float* out; char* ws;
};
constexpr int NT = 512;
constexpr int LDS_BYTES = 144 * 1024;

__global__ void __launch_bounds__(NT, 2) mega(Params p) {
    cg::grid_group grid = cg::this_grid();
    extern __shared__ __attribute__((aligned(16))) unsigned char smem[];
    char* ws = p.ws; float* out = p.out;
    Bufs b; b.ws = ws; b.pool_scale = p.pool_scale; b.xin = p.x; b.xout = out;
#if PROBE
    b.kf = (h16*)out; b.vf = (h16*)out + (size_t)T * 512;
#else
    b.kf = (h16*)(ws + WS_ARR) + (size_t)A_AK * ((size_t)T * 512); b.vf = (h16*)(ws + WS_ARR) + (size_t)A_AV * ((size_t)T * 512);
#endif
    const size_t ASZ = (size_t)T * 512;
    const int G = gridDim.x, bx = blockIdx.x, vc = (G % 8 == 0) ? (bx % 8) * (G / 8) + bx / 8 : bx;
    g8::G8_LAS_T lds = (g8::G8_LAS_T)smem;
#if PROBE
    {
        float* diag = (float*)(ws + WS_DIAG);
#pragma unroll 1
        for (int step = 0; step < 7; ++step) {
            { char* w_ = p.ws; asm volatile("" : "+s"(w_)); b.ws = w_; }
            float* BT = b.BT(); h16* ARR = b.ARR();
            h16* YF = b.POOLED();
            if (step == 0) {
                if (blockIdx.x == 0 && threadIdx.x < 4) diag[threadIdx.x] = 0.f;
                ph_convert_w(p.w_in, IN_COLS, D, b.W1T(), D, N1, 1, 0, (float*)smem);
                for (int ll = 0; ll < 2; ++ll) {
                    ph_convert_w(p.w_mem_kv + (size_t)ll * D * 1024, 1024, D, b.WKVT() + (size_t)ll * 1024 * D, D, 1024, 0, 0, (float*)smem);
                    ph_rmsnorm<false>(p.mem, p.mem_norm_g + (size_t)ll * D, (void*)(b.MEMN() + (size_t)ll * 1024 * D), 1024);
                }
                ph_bias_tab(p.rel_bias, BT, (int*)(b.ws + WS_BKT));
                ph_rmsnorm<false>(p.x, p.norm_g, (void*)b.H(), T);
            } else if (step == 1) {
                Sched s{PH_GEMM1, 0, G, bx, vc, b}; Epi e{b}; g8::gemm_phase(lds, s, e);
            } else if (step == 2) {
                pe::Tens X{ARR + A_IQ * ASZ, b.IK(), ARR + A_AQ * ASZ, ARR + A_AZ * ASZ, b.kf, b.vf, b.IW(), BT, (const int*)(b.ws + WS_BKT), YF, nullptr};
                pe::phase(X, (pe::lu8*)smem, G, vc);
            } else if (step == 3) {
                ph_dsa(ARR + A_AQ * ASZ, ARR + A_AK * ASZ, ARR + A_AV * ASZ, ARR + A_AZ * ASZ, ARR + A_IQ * ASZ, b.IK(), b.IW(), BT, ARR + A_AQ * ASZ, (unsigned*)smem);
            } else if (step == 4) {
                const h16* YN = ARR + A_AQ * ASZ; float sd = 0.f, sn = 0.f;
                for (size_t i = (size_t)blockIdx.x * 512 + threadIdx.x; i < ASZ; i += (size_t)gridDim.x * 512) { const float a = (float)YF[i], c = (float)YN[i]; sd += (a - c) * (a - c); sn += c * c; }
                sd = wave_sum(sd); sn = wave_sum(sn);
                if ((threadIdx.x & 63) == 0) { atomicAdd(diag, sd); atomicAdd(diag + 1, sn); }
            } else if (step == 5) {
                const float msd = diag[0] / fmaxf(diag[1], 1e-30f);
                const float val = 100.f * (10.f + log10f(fmaxf(msd, 1e-9f)));
                for (size_t i = (size_t)blockIdx.x * 512 + threadIdx.x; i < (size_t)T * D; i += (size_t)gridDim.x * 512) out[i] = val;
            }
            if (step < 6) grid.sync();
        }
    }
}

#else
    constexpr int NSTEPS = 2 + 6 * DEPTH;
#pragma unroll 1
    for (int step = 0; step < NSTEPS; ++step) {
        const int l = (step - 1) / 6, k = (step - 1) - 6 * l;
        { char* w_ = p.ws; asm volatile("" : "+s"(w_)); b.ws = w_; }
        float* BT = b.BT(); h16* ARR = b.ARR();
        if (step == 0) {
            for (int ll = 0; ll < DEPTH; ++ll) {
                ph_convert_w(p.w_in + (size_t)ll * D * IN_COLS, IN_COLS, D, b.W1T() + (size_t)ll * N1 * D, D, N1, 1, 0, (float*)smem);
                ph_convert_w(p.w_in + (size_t)ll * D * IN_COLS, IN_COLS, D, b.WGT() + (size_t)ll * 3072 * D, D, 3072, 0, 4680, (float*)smem);
                for (int i = 0; i < 3; ++i) ph_convert_w(p.w_branch + ((size_t)ll * 3 + i) * 512 * 1024, 1024, 512, b.WBT() + ((size_t)ll * 3 + i) * 1024 * 512, 512, 1024, 0, 0, (float*)smem);
                ph_convert_w(p.w_out + (size_t)ll * D * D, D, D, b.WOT() + (size_t)ll * D * D, D, D, 0, 0, (float*)smem);
                ph_convert_w(p.w_mem_kv + (size_t)ll * D * 1024, 1024, D, b.WKVT() + (size_t)ll * 1024 * D, D, 1024, 0, 0, (float*)smem);
                ph_convert_pw(p.pool_w + (size_t)ll * 4 * 128 * 128, b.PWT() + (size_t)ll * 512 * 256);
                ph_rmsnorm<false>(p.mem, p.mem_norm_g + (size_t)ll * D, (void*)(b.MEMN() + (size_t)ll * 1024 * D), 1024);
            }
            ph_bias_tab(p.rel_bias, BT, (int*)(b.ws + WS_BKT));
        } else if (step == NSTEPS - 1) {
            ph_rmsnorm<true>((const float*)out, p.final_g, (void*)out, T);
        } else {
            b.xin = l == 0 ? p.x : (const float*)out; b.pool_scale = p.pool_scale + (size_t)l * 512;
            if (k == 0) {
                ph_rmsnorm<false>(b.xin, p.norm_g + (size_t)l * D, (void*)b.H(), T);
            } else if (k == 2) {
                ph_pooled(ARR + A_POOLU * ASZ, b.POOLED());
                ma::phase(ARR + A_MQ * ASZ, b.MKV() + (size_t)l * 1024 * 1024, ARR + A_MZ * ASZ, ARR + A_MQ * ASZ, (ma::lu8*)smem, G, vc);
                pe::Tens X{ARR + A_IQ * ASZ, b.IK(), ARR + A_AQ * ASZ, ARR + A_AZ * ASZ, b.kf, b.vf, b.IW(), BT, (const int*)(b.ws + WS_BKT), ARR + A_AQ * ASZ, nullptr};
                pe::phase(X, (pe::lu8*)smem, G, vc);
            } else {
                const int ph = k == 1 ? PH_GEMM1 : k == 3 ? PH_POOLMIX : k == 4 ? PH_MERGE : PH_OUT;
                Sched s{ph, l, G, bx, vc, b}; Epi e{b}; g8::gemm_phase(lds, s, e);
            }
        }
        if (step < NSTEPS - 1) grid.sync();
    }
}

#endif
extern "C" void kernel_launch(void* const* d_in, const int* in_sizes, int n_in, void* d_out, int out_size, void* d_ws, size_t ws_size, hipStream_t stream) {
    static int grid_blocks = 0;
    if (!grid_blocks) {
        int dev = 0, cus = 0, per_cu = 0;
        (void)hipGetDevice(&dev);
        (void)hipDeviceGetAttribute(&cus, hipDeviceAttributeMultiprocessorCount, dev);
        (void)hipFuncSetAttribute((const void*)mega, hipFuncAttributeMaxDynamicSharedMemorySize, LDS_BYTES);
        (void)hipOccupancyMaxActiveBlocksPerMultiprocessor(&per_cu, mega, NT, LDS_BYTES);
        if (per_cu < 1) per_cu = 1;
        grid_blocks = cus * 1;
    }
    Params p{};
    p.x = (const float*)d_in[0]; p.mem = (const float*)d_in[1]; p.norm_g = (const float*)d_in[2]; p.w_in = (const float*)d_in[3];
    p.pool_w = (const float*)d_in[4]; p.pool_scale = (const float*)d_in[5]; p.mem_norm_g = (const float*)d_in[6]; p.w_mem_kv = (const float*)d_in[7];
    p.w_branch = (const float*)d_in[8]; p.w_out = (const float*)d_in[9]; p.rel_bias = (const float*)d_in[10]; p.final_g = (const float*)d_in[11];
    p.out = (float*)d_out; p.ws = (char*)d_ws;
    void* args[] = {&p};
    hipError_t e = hipLaunchCooperativeKernel((void*)mega, dim3(grid_blocks), dim3(NT), args, LDS_BYTES, stream);
    if (e != hipSuccess) fprintf(stderr, "cooperative launch failed: %s (grid %d)\n", hipGetErrorString(e), grid_blocks);
}
```
